# Optimizing an MI355X kernel written in HIP

```python
import math
import jax
import jax.numpy as jnp
from jax import lax
import numpy as np

D_MODEL = 2048
BATCH = 1
SEQ = 8192
DEPTH = 1

GRID_W = 64
CTX_LEN = 256
N_MOD = 9
D_FF = 5632
NORM_EPS = 1e-6

MLA_HEADS = 16
Q_LORA = 512
KV_LORA = 512
QK_NOPE = 128
QK_ROPE = 64
V_HEAD = 128
ROPE_AXIS = QK_ROPE // 2
ROPE_THETA = 10000.0
ATTN_SCALE = (QK_NOPE + QK_ROPE) ** -0.5
Q_BLOCK = 128

HY_WIDTH = 1024
HY_ORDER = 2
HY_SHORT = 3
HY_EMB = 33
HY_BANDS = (HY_EMB - 1) // 2
HY_FILTER_W = 64
HY_TARGET = 1e-2
HY_FAST_DECAY = 0.3
HY_SLOW_DECAY = 1.5
HY_MAX_DECAY = math.log(HY_TARGET) / HY_FAST_DECAY
HY_MIN_DECAY = math.log(HY_TARGET) / HY_SLOW_DECAY
HY_MOD_SHIFT = 0.05

Q_END = Q_LORA
KV_END = Q_END + KV_LORA
KR_END = KV_END + QK_ROPE
HY_END = KR_END + 3 * HY_WIDTH
D_IN = HY_END + 2 * D_MODEL

kernel_name = 'hybrid_mla_hyena_dit_block'


def rms_norm(x, g):
    xf = x.astype(jnp.float32)
    y = xf * lax.rsqrt(jnp.mean(xf * xf, axis=-1, keepdims=True) + NORM_EPS)
    return (y * g.astype(jnp.float32)).astype(x.dtype)


def modulate(h, shift, scale):
    return h * (1.0 + scale) + shift


def swiglu(h, w13, w2):
    a, b = jnp.split(h @ w13, 2, axis=-1)
    return (jax.nn.silu(a) * b) @ w2


def half_ffn(s, shift, scale, gate, g, w13, w2):
    return s + 0.5 * gate * swiglu(modulate(rms_norm(s, g), shift, scale), w13, w2)


def split_proj(p):
    return p[..., :Q_END], p[..., Q_END:KV_END], p[..., KV_END:KR_END], p[..., KR_END:HY_END], p[..., HY_END:]


def rope_half(x, ang):
    x1, x2 = jnp.split(x, 2, axis=-1)
    cos = jnp.cos(ang).astype(x.dtype)
    sin = jnp.sin(ang).astype(x.dtype)
    return jnp.concatenate([x1 * cos - x2 * sin, x1 * sin + x2 * cos], axis=-1)


def rope_2d(x, ang_row, ang_col):
    xr, xc = jnp.split(x, 2, axis=-1)
    return jnp.concatenate([rope_half(xr, ang_row), rope_half(xc, ang_col)], axis=-1)


def mla_query(p_q, g_q, w_uq):
    B, L, _ = p_q.shape
    q = (rms_norm(p_q, g_q) @ w_uq).reshape(B, L, MLA_HEADS, QK_NOPE + QK_ROPE)
    return q[..., :QK_NOPE], q[..., QK_NOPE:]


def mla_kv(p_kv, g_kv, w_ukv):
    B, L, _ = p_kv.shape
    kv = (rms_norm(p_kv, g_kv) @ w_ukv).reshape(B, L, MLA_HEADS, QK_NOPE + V_HEAD)
    return kv[..., :QK_NOPE], kv[..., QK_NOPE:]


def join_key(k_nope, k_rope):
    kr = jnp.broadcast_to(k_rope[:, :, None, :], k_nope.shape[:-1] + (QK_ROPE,))
    return jnp.concatenate([k_nope, kr], axis=-1)


def softmax_attend(q, k, v):
    s = jnp.einsum('bqhd,bkhd->bhqk', q, k, preferred_element_type=jnp.float32) * ATTN_SCALE
    p = jax.nn.softmax(s, axis=-1).astype(v.dtype)
    return jnp.einsum('bhqk,bkhd->bqhd', p, v)


def blocked_attention(q, k, v):
    B, S, H, Dq = q.shape
    nb = S // Q_BLOCK
    qb = q.reshape(B, nb, Q_BLOCK, H, Dq).transpose(1, 0, 2, 3, 4)
    out = lax.map(lambda qblk: softmax_attend(qblk, k, v), qb)
    return out.transpose(1, 0, 2, 3, 4).reshape(B, S, H, v.shape[-1])


def hyena_filters(L, w1, b1, w2, b2, w3, freq):
    f32 = lambda a: a.astype(jnp.float32)
    pos = jnp.arange(L, dtype=jnp.float32)[:, None]
    t01 = pos / max(L - 1, 1)
    bands = jnp.linspace(1e-4, HY_BANDS - 1, HY_BANDS, dtype=jnp.float32)[None, :]
    ang = bands * (2.0 * math.pi / L) * pos
    z = jnp.concatenate([t01, jnp.cos(ang), -jnp.sin(ang)], axis=-1)
    h = jnp.sin(f32(freq) * (z @ f32(w1) + f32(b1)))
    h = jnp.sin(f32(freq) * (h @ f32(w2) + f32(b2)))
    h = (h @ f32(w3)).reshape(L, HY_ORDER, HY_WIDTH)
    dist = (jnp.abs(pos - (L // 2)) / (L / 2.0))[:, :, None]
    decay = jnp.abs(jnp.linspace(HY_MIN_DECAY, HY_MAX_DECAY, HY_WIDTH, dtype=jnp.float32))
    h = h * (jnp.exp(-dist * decay) + HY_MOD_SHIFT)
    return h * lax.rsqrt(jnp.sum(h * h, axis=0, keepdims=True) + NORM_EPS)


def short_conv(u, w, b):
    L = u.shape[1]
    up = jnp.pad(u, ((0, 0), (1, 1), (0, 0)))
    return up[:, :L] * w[0] + up[:, 1:L + 1] * w[1] + up[:, 2:] * w[2] + b


def fft_long_conv(u, h):
    L = u.shape[1]
    n = 2 * L
    uf = jnp.fft.rfft(u.astype(jnp.float32), n=n, axis=1)
    hf = jnp.fft.rfft(h, n=n, axis=0)
    y = jnp.fft.irfft(uf * hf[None], n=n, axis=1)[:, L // 2:L // 2 + L]
    return y.astype(u.dtype)


def hyena(p_hy, conv_w, conv_b, filt, skip):
    v, x1, x2 = jnp.split(short_conv(p_hy, conv_w, conv_b), 3, axis=-1)
    z = x1 * (fft_long_conv(v, filt[:, 0]) + skip[0] * v)
    return x2 * (fft_long_conv(z, filt[:, 1]) + skip[1] * z)


def merge_branches(y_attn, y_hy, p_gate, w_attn_o, w_hy_o, w_out):
    g_attn, g_hy = jnp.split(p_gate, 2, axis=-1)
    y = jax.nn.sigmoid(g_attn) * (y_attn @ w_attn_o) + jax.nn.sigmoid(g_hy) * (y_hy @ w_hy_o)
    return y @ w_out


def setup_inputs(seed: int = 0) -> dict:
    key = jax.random.key(seed)
    ks = iter(jax.random.split(key, 40))
    D = D_MODEL
    L = DEPTH

    def nrm(shape, scale):
        return jax.random.normal(next(ks), shape, jnp.float32) * scale

    def gain(shape):
        return 1.0 + nrm(shape, 0.02)

    return {
        'x': nrm((BATCH, SEQ, D), 1.0),
        'c': nrm((BATCH, D), 1.0),
        'ctx': nrm((BATCH, CTX_LEN, D), 1.0),
        'c_ctx': nrm((D,), 1.0),
        'w_mod': nrm((L, D, N_MOD * D), 0.5 * D ** -0.5),
        'b_mod': nrm((L, N_MOD * D), 0.02),
        'g_ffn1': gain((L, D)),
        'w13_ffn1': nrm((L, D, 2 * D_FF), D ** -0.5),
        'w2_ffn1': nrm((L, D_FF, D), D_FF ** -0.5),
        'g_mix': gain((L, D)),
        'w_in': nrm((L, D, D_IN), D ** -0.5),
        'g_q': gain((L, Q_LORA)),
        'w_uq': nrm((L, Q_LORA, MLA_HEADS * (QK_NOPE + QK_ROPE)), Q_LORA ** -0.5),
        'g_kv': gain((L, KV_LORA)),
        'w_ukv': nrm((L, KV_LORA, MLA_HEADS * (QK_NOPE + V_HEAD)), KV_LORA ** -0.5),
        'w_attn_o': nrm((L, MLA_HEADS * V_HEAD, D), (MLA_HEADS * V_HEAD) ** -0.5),
        'hy_conv_w': nrm((L, HY_SHORT, 3 * HY_WIDTH), HY_SHORT ** -0.5),
        'hy_conv_b': nrm((L, 3 * HY_WIDTH), 0.02),
        'hy_w1': nrm((L, HY_EMB, HY_FILTER_W), HY_EMB ** -0.5),
        'hy_b1': nrm((L, HY_FILTER_W), 0.02),
        'hy_w2': nrm((L, HY_FILTER_W, HY_FILTER_W), HY_FILTER_W ** -0.5),
        'hy_b2': nrm((L, HY_FILTER_W), 0.02),
        'hy_w3': nrm((L, HY_FILTER_W, HY_ORDER * HY_WIDTH), HY_FILTER_W ** -0.5),
        'hy_freq': gain((L, HY_FILTER_W)),
        'hy_skip': nrm((L, HY_ORDER, HY_WIDTH), 1.0),
        'w_hy_o': nrm((L, HY_WIDTH, D), HY_WIDTH ** -0.5),
        'w_out': nrm((L, D, D), D ** -0.5),
        'g_ffn2': gain((L, D)),
        'w13_ffn2': nrm((L, D, 2 * D_FF), D ** -0.5),
        'w2_ffn2': nrm((L, D_FF, D), D_FF ** -0.5),
        'g_final': gain((D,)),
    }


def reference(x, c, ctx, c_ctx, w_mod, b_mod, g_ffn1, w13_ffn1, w2_ffn1, g_mix, w_in,
              g_q, w_uq, g_kv, w_ukv, w_attn_o, hy_conv_w, hy_conv_b, hy_w1, hy_b1,
              hy_w2, hy_b2, hy_w3, hy_freq, hy_skip, w_hy_o, w_out, g_ffn2, w13_ffn2,
              w2_ffn2, g_final):
    B, S, _ = x.shape
    CL = ctx.shape[1]
    ROWS = S // GRID_W
    rows = jnp.repeat(jnp.arange(ROWS, dtype=jnp.float32), GRID_W)
    cols = jnp.tile(jnp.arange(GRID_W, dtype=jnp.float32), ROWS)
    inv_freq = ROPE_THETA ** (-jnp.arange(0, ROPE_AXIS, 2, dtype=jnp.float32) / ROPE_AXIS)
    ang_row = rows[:, None] * inv_freq
    ang_col = cols[:, None] * inv_freq

    for li in range(DEPTH):
        last = li == DEPTH - 1
        mx = (jax.nn.silu(c) @ w_mod[li] + b_mod[li]).reshape(B, N_MOD, 1, D_MODEL)
        mc = (jax.nn.silu(c_ctx) @ w_mod[li] + b_mod[li]).reshape(N_MOD, D_MODEL)

        x = half_ffn(x, mx[:, 0], mx[:, 1], mx[:, 2], g_ffn1[li], w13_ffn1[li], w2_ffn1[li])
        ctx = half_ffn(ctx, mc[0], mc[1], mc[2], g_ffn1[li], w13_ffn1[li], w2_ffn1[li])

        hx = modulate(rms_norm(x, g_mix[li]), mx[:, 3], mx[:, 4])
        hc = modulate(rms_norm(ctx, g_mix[li]), mc[3], mc[4])
        xq, xkv, xkr, xhy, xgate = split_proj(hx @ w_in[li])
        if last:
            ckvr = hc @ w_in[li][:, Q_END:KR_END]
            ckv, ckr = ckvr[..., :KV_LORA], ckvr[..., KV_LORA:]
        else:
            cq, ckv, ckr, chy, cgate = split_proj(hc @ w_in[li])

        q_nope, q_rope = mla_query(xq, g_q[li], w_uq[li])
        q_lat = jnp.concatenate([q_nope, rope_2d(q_rope, ang_row[:, None], ang_col[:, None])], axis=-1)
        k_nope, v_lat = mla_kv(xkv, g_kv[li], w_ukv[li])
        k_lat = join_key(k_nope, rope_2d(xkr, ang_row, ang_col))
        kc_nope, v_ctx = mla_kv(ckv, g_kv[li], w_ukv[li])
        k_ctx = join_key(kc_nope, ckr)
        k_all = jnp.concatenate([k_lat, k_ctx], axis=1)
        v_all = jnp.concatenate([v_lat, v_ctx], axis=1)
        attn_x = blocked_attention(q_lat, k_all, v_all).reshape(B, S, MLA_HEADS * V_HEAD)

        filt_x = hyena_filters(S, hy_w1[li], hy_b1[li], hy_w2[li], hy_b2[li], hy_w3[li], hy_freq[li])
        hy_x = hyena(xhy, hy_conv_w[li], hy_conv_b[li], filt_x, hy_skip[li])
        x_mix = merge_branches(attn_x, hy_x, xgate, w_attn_o[li], w_hy_o[li], w_out[li])

        if not last:
            cq_nope, cq_rope = mla_query(cq, g_q[li], w_uq[li])
            q_ctx = jnp.concatenate([cq_nope, cq_rope], axis=-1)
            attn_c = softmax_attend(q_ctx, k_ctx, v_ctx).reshape(B, CL, MLA_HEADS * V_HEAD)
            filt_c = hyena_filters(CL, hy_w1[li], hy_b1[li], hy_w2[li], hy_b2[li], hy_w3[li], hy_freq[li])
            hy_c = hyena(chy, hy_conv_w[li], hy_conv_b[li], filt_c, hy_skip[li])
            ctx = ctx + mc[5] * merge_branches(attn_c, hy_c, cgate, w_attn_o[li], w_hy_o[li], w_out[li])
            ctx = half_ffn(ctx, mc[6], mc[7], mc[8], g_ffn2[li], w13_ffn2[li], w2_ffn2[li])

        x = x + mx[:, 5] * x_mix
        x = half_ffn(x, mx[:, 6], mx[:, 7], mx[:, 8], g_ffn2[li], w13_ffn2[li], w2_ffn2[li])

    return rms_norm(x, g_final)
```

```cpp
#include <hip/hip_runtime.h>
#include <hip/hip_cooperative_groups.h>
#include <cstdio>
#include <cstdint>
#include <cmath>

#ifndef MK_N_LAUNCHES
#define MK_N_LAUNCHES 1
#endif
constexpr int N_PHASES = 14;

constexpr int DM = 2048, SEQ = 8192, CTXL = 256, MTOT = SEQ + CTXL, DFF = 5632;
constexpr int HEADS = 16, QLORA = 512, KVLORA = 512, DNOPE = 128, DROPE = 64, DVH = 128, DQH = 192;
constexpr int HYW = 1024, NINP = 8448;
constexpr float NORM_EPS = 1e-6f;

constexpr size_t WS_CTL = 0;
constexpr size_t WS_MODS = 64 * 1024;
constexpr size_t WS_ROPE = 256 * 1024;
constexpr size_t WS_QSS = 320 * 1024;
constexpr size_t WS_KVSS = 640 * 1024;
constexpr size_t WS_W13A = 1u << 20;
constexpr size_t WS_W2A = WS_W13A + (size_t)11264 * 2048 * 2;
constexpr size_t WS_WIN = WS_W2A + (size_t)2048 * 5632 * 2;
constexpr size_t WS_WUQ = WS_WIN + (size_t)NINP * 2048 * 2;
constexpr size_t WS_WUKV = WS_WUQ + (size_t)3072 * 512 * 2;
constexpr size_t WS_WAO = WS_WUKV + (size_t)4096 * 512 * 2;
constexpr size_t WS_WHO = WS_WAO + (size_t)2048 * 2048 * 2;
constexpr size_t WS_WOUT = WS_WHO + (size_t)2048 * 1024 * 2;
constexpr size_t WS_W13B = WS_WOUT + (size_t)2048 * 2048 * 2;
constexpr size_t WS_W2B = WS_W13B + (size_t)11264 * 2048 * 2;
constexpr size_t WS_HN = WS_W2B + (size_t)2048 * 5632 * 2;
constexpr size_t WS_ACT = WS_HN + (size_t)MTOT * 2048 * 2;
constexpr size_t WS_X1 = WS_ACT + (size_t)MTOT * DFF * 2;
constexpr size_t WS_HYT = WS_X1 + (size_t)MTOT * 2048 * 4;
constexpr size_t WS_KV = WS_HYT + (size_t)3072 * 8192 * 2;
constexpr size_t WS_END = WS_KV + (size_t)MTOT * 4096 * 2;
constexpr size_t WS_Q = WS_W13A;
constexpr size_t WS_T = WS_W13A;
constexpr size_t WS_HYO = WS_WIN;
constexpr size_t WS_AX = WS_HN;
constexpr size_t WS_GATES = WS_ACT;
constexpr size_t WS_PQ = WS_GATES + (size_t)8192 * 4096 * 2;
constexpr size_t WS_PKV = WS_PQ + (size_t)8192 * 512 * 2;
constexpr size_t WS_KR = WS_PKV + (size_t)MTOT * 512 * 2;
constexpr size_t WS_HYTOK = WS_HYT;
constexpr size_t WS_Y = WS_KV;
static_assert(WS_KR + (size_t)MTOT * 64 * 2 <= WS_X1, "ACT overlay");
static_assert((size_t)8192 * 3072 * 2 <= WS_WIN - WS_W13A && (size_t)8192 * 2048 * 4 <= WS_WIN - WS_W13A, "Q/T overlay");

constexpr int LDS_BYTES = 163840;
constexpr int LDS_CTL_OFF = LDS_BYTES - 512;

typedef unsigned short bf16;
#define GAS __attribute__((address_space(1)))
#define LAS __attribute__((address_space(3)))
typedef unsigned v4u __attribute__((ext_vector_type(4)));
typedef unsigned v2u __attribute__((ext_vector_type(2)));
typedef float v4f __attribute__((ext_vector_type(4)));
#define LDS_WAIT() asm volatile("s_waitcnt lgkmcnt(0)" ::: "memory")
#define VM_WAIT() asm volatile("s_waitcnt vmcnt(0)" ::: "memory")
__device__ __forceinline__ unsigned f2bf(float f) { unsigned u = __builtin_bit_cast(unsigned, f); return (u + 0x7fffu + ((u >> 16) & 1u)) >> 16; }
__device__ __forceinline__ unsigned pk2(float lo, float hi) { return f2bf(lo) | (f2bf(hi) << 16); }
__device__ __forceinline__ float bf2f(unsigned short b) { return __builtin_bit_cast(float, (unsigned)b << 16); }
__device__ __forceinline__ float fast_sigmoid(float v) { return __builtin_amdgcn_rcpf(1.f + __builtin_amdgcn_exp2f(-1.4426950408889634f * v)); }
__device__ __forceinline__ float wave_sum(float v) {
#pragma unroll
    for (int o = 1; o < 64; o <<= 1) v += __shfl_xor(v, o);
    return v;
}

__device__ __forceinline__ int lane_id_fresh() { int l; asm volatile("v_mbcnt_lo_u32_b32 %0, -1, 0\n\tv_mbcnt_hi_u32_b32 %0, -1, %0" : "=v"(l)); return l; }
namespace pg8 {
#define PG8_LAS __attribute__((address_space(3)))
typedef unsigned short bf16_t;
typedef short bf16x8 __attribute__((ext_vector_type(8)));
typedef float f32x4 __attribute__((ext_vector_type(4)));
typedef unsigned u32x4 __attribute__((ext_vector_type(4)));
constexpr int BM = 256, BK = 64, HALF = 128, HTB = HALF * BK * 2  , STAGE_BYTES = 8 * HTB, NXCD = 8, WGM = 8;

__host__ __device__ __forceinline__ int lds_byte(int r, int c) { const int st = (r >> 4) * 2 + (c >> 5), rr = r & 15, cc = c & 31, ob = rr * 64 + cc * 2; return st * 1024 + (ob ^ (((ob >> 9) & 1) << 5)); }
__host__ __device__ __forceinline__ void stage_rc(int b, int& R, int& C) { const int st = b / 1024, sb = b % 1024, swz = sb ^ (((sb >> 9) & 1) << 5); R = (st >> 1) * 16 + swz / 64; C = (st & 1) * 32 + (swz % 64) / 2; }
__host__ __device__ __forceinline__ int perm32(int rho) { const int n = rho >> 4, i = rho & 15; return 8 * (i >> 2) + 4 * n + (i & 3); }

struct Unit { int pm, pn; };
struct Gemm { const bf16_t* A; const bf16_t* Bt; int M, N, K; };

struct StaticOrder {
    int nM, nN, nwg, G, c;
    __host__ __device__ void init(int M, int N, int G_, int c_) { nM = M / BM; nN = N / BM; nwg = nM * nN; G = G_; c = c_; }
    __host__ __device__ bool next(int i, Unit& u) const {
        const long L = (long)i * G + c; if (L >= nwg) return false;
        int wgid = (int)L; { const int q = nwg / NXCD, r = nwg % NXCD, xcd = wgid % NXCD, off = wgid / NXCD; wgid = (xcd < r ? xcd * (q + 1) : r * (q + 1) + (xcd - r) * q) + off; }
        const int nig = WGM * nN, gid = wgid / nig, fm = gid * WGM, gsz = (nM - fm) < WGM ? (nM - fm) : WGM;
        u.pm = fm + ((wgid % nig) % gsz); u.pn = (wgid % nig) / gsz; return true;
    }
    __device__ __forceinline__ void a_ready(const Unit&) const {}
    __device__ __forceinline__ void done(const Unit&) const {}
};


typedef float f32x2_t __attribute__((ext_vector_type(2))); typedef __bf16 bf16x2_t __attribute__((ext_vector_type(2)));
__device__ __forceinline__ unsigned cvt_pk_bf16(float lo, float hi) { f32x2_t v = {lo, hi}; bf16x2_t b = __builtin_convertvector(v, bf16x2_t); return __builtin_bit_cast(unsigned, b); }
__device__ __forceinline__ u32x4 pack8(const f32x4 v0, const f32x4 v1) { u32x4 w; w.x = cvt_pk_bf16(v0[0], v0[1]); w.y = cvt_pk_bf16(v0[2], v0[3]); w.z = cvt_pk_bf16(v1[0], v1[1]); w.w = cvt_pk_bf16(v1[2], v1[3]); return w; }
__device__ __forceinline__ float sigm(float v) { return __builtin_amdgcn_rcpf(1.f + __builtin_amdgcn_exp2f(-1.4426950408889634f * v)); }

struct EpiSwiGLU {
    static constexpr bool PERM = true, AFTER_DRAIN = false;
    bf16_t* O; int ldc;
    __device__ __forceinline__ void operator()(const f32x4 (&acc)[2][2][4][2], const Unit& u, int wr, int wc, int fr, int fq) const {
        const int row0 = u.pm * BM + wr * 64 + fr, col0 = u.pn * HALF + wc * 32 + 8 * fq;
#pragma unroll
        for (int ai = 0; ai < 2; ++ai)
#pragma unroll
            for (int m = 0; m < 4; ++m) {
                bf16_t* rowp = O + (size_t)(row0 + ai * HALF + m * 16) * ldc + col0;
                f32x4 v[2];
#pragma unroll
                for (int n = 0; n < 2; ++n)
#pragma unroll
                    for (int e = 0; e < 4; ++e) { const float a = acc[ai][0][m][n][e], b = acc[ai][1][m][n][e]; v[n][e] = a * sigm(a) * b; }
                *(u32x4*)rowp = pack8(v[0], v[1]);
            }
    }
};
struct EpiResid {
    static constexpr bool PERM = false, AFTER_DRAIN = false;
    const float* base_x; const float* base_c; const float* gate_x; const float* gate_c; float* out; float coef;
    __device__ __forceinline__ void operator()(const f32x4 (&acc)[2][2][4][2], const Unit& u, int wr, int wc, int fr, int fq) const {
        const bool isc = u.pm >= 32;
        const int row0 = u.pm * BM + wr * 64 + fr, col0 = u.pn * BM + wc * 32 + 4 * fq;
        const float* gate = isc ? gate_c : gate_x;
        f32x4 gv[2][2];
#pragma unroll
        for (int bj = 0; bj < 2; ++bj)
#pragma unroll
            for (int n = 0; n < 2; ++n) gv[bj][n] = *(const f32x4*)(gate + col0 + bj * HALF + n * 16) * coef;
#pragma unroll
        for (int ai = 0; ai < 2; ++ai)
#pragma unroll
            for (int m = 0; m < 4; ++m) {
                const int row = row0 + ai * HALF + m * 16;
                const float* bp = (isc ? base_c + (size_t)(row - 8192) * 2048 : base_x + (size_t)row * 2048) + col0;
                float* op = out + (size_t)row * 2048 + col0;
#pragma unroll
                for (int bj = 0; bj < 2; ++bj)
#pragma unroll
                    for (int n = 0; n < 2; ++n) { const f32x4 b = *(const f32x4*)(bp + bj * HALF + n * 16); *(f32x4*)(op + bj * HALF + n * 16) = b + gv[bj][n] * acc[ai][bj][m][n]; }
            }
    }
};
struct EpiInProj {
    static constexpr bool PERM = true, AFTER_DRAIN = false;
    bf16_t* pq; bf16_t* pkv; bf16_t* kr; bf16_t* hyT; bf16_t* gates; float* qss; float* kvss; const float* rope;
    __device__ __forceinline__ void operator()(const f32x4 (&acc)[2][2][4][2], const Unit& u, int wr, int wc, int fr, int fq) const {
        const int row0 = u.pm * BM + wr * 64 + fr, pn = u.pn;
        if (pn < 4) {
            bf16_t* O = pn < 2 ? pq : pkv; float* ss = pn < 2 ? qss : kvss; const int t = pn & 1;
            const int col0 = t * BM + wc * 32 + 8 * fq;
#pragma unroll
            for (int ai = 0; ai < 2; ++ai)
#pragma unroll
                for (int m = 0; m < 4; ++m) {
                    const int row = row0 + ai * HALF + m * 16; float s = 0.f;
#pragma unroll
                    for (int bj = 0; bj < 2; ++bj) {
                        const f32x4 v0 = acc[ai][bj][m][0], v1 = acc[ai][bj][m][1];
                        s += (v0[0] * v0[0] + v0[1] * v0[1]) + (v0[2] * v0[2] + v0[3] * v0[3]) + (v1[0] * v1[0] + v1[1] * v1[1]) + (v1[2] * v1[2] + v1[3] * v1[3]);
                        *(u32x4*)(O + (size_t)row * 512 + col0 + bj * HALF) = pack8(v0, v1);
                    }
                    s += __shfl_xor(s, 16); s += __shfl_xor(s, 32);
                    if (fq == 0) ss[(size_t)row * 8 + t * 4 + wc] = s;
                }
        } else if (pn < 16) {
            const int ch0 = (pn - 4) * BM + wc * 32 + 8 * fq;
#pragma unroll
            for (int ai = 0; ai < 2; ++ai)
#pragma unroll
                for (int m = 0; m < 4; ++m) {
                    const int row = row0 + ai * HALF + m * 16;
#pragma unroll
                    for (int bj = 0; bj < 2; ++bj)
#pragma unroll
                        for (int n = 0; n < 2; ++n)
#pragma unroll
                            for (int e = 0; e < 4; ++e) hyT[(size_t)(ch0 + bj * HALF + 4 * n + e) * 8192 + row] = (bf16_t)(cvt_pk_bf16(acc[ai][bj][m][n][e], 0.f) & 0xffffu);
                }
        } else if (pn < 32) {
            const int col0 = (pn - 16) * BM + wc * 32 + 8 * fq;
#pragma unroll
            for (int ai = 0; ai < 2; ++ai)
#pragma unroll
                for (int m = 0; m < 4; ++m) {
                    const int row = row0 + ai * HALF + m * 16;
#pragma unroll
                    for (int bj = 0; bj < 2; ++bj) {
                        f32x4 v0 = acc[ai][bj][m][0], v1 = acc[ai][bj][m][1];
#pragma unroll
                        for (int e = 0; e < 4; ++e) { v0[e] = sigm(v0[e]); v1[e] = sigm(v1[e]); }
                        *(u32x4*)(gates + (size_t)row * 4096 + col0 + bj * HALF) = pack8(v0, v1);
                    }
                }
        } else {
            if (wc < 2) {
#pragma unroll
                for (int ai = 0; ai < 2; ++ai)
#pragma unroll
                    for (int m = 0; m < 4; ++m) {
                        const int row = row0 + ai * HALF + m * 16;
                        f32x4 v[2] = {acc[ai][0][m][0], acc[ai][0][m][1]};
                        if (row < 8192) {
                            const int pos = wc == 0 ? (row >> 6) : (row & 63);
#pragma unroll
                            for (int n = 0; n < 2; ++n) {
                                const f32x4 cs = *(const f32x4*)(rope + (size_t)(pos * 16 + 4 * fq + 2 * n) * 2);
                                const float a0 = v[n][0], b0 = v[n][1], a1 = v[n][2], b1 = v[n][3];
                                v[n][0] = a0 * cs[0] - b0 * cs[1]; v[n][1] = a0 * cs[1] + b0 * cs[0];
                                v[n][2] = a1 * cs[2] - b1 * cs[3]; v[n][3] = a1 * cs[3] + b1 * cs[2];
                            }
                        }
                        *(u32x4*)(kr + (size_t)row * 64 + wc * 32 + 8 * fq) = pack8(v[0], v[1]);
                    }
            }
        }
    }
};
struct EpiQUp {
    static constexpr bool PERM = true, AFTER_DRAIN = false;
    bf16_t* Q; const float* qss; const float* rope;
    __device__ __forceinline__ void operator()(const f32x4 (&acc)[2][2][4][2], const Unit& u, int wr, int wc, int fr, int fq) const {
        const int row0 = u.pm * BM + wr * 64 + fr;
#pragma unroll
        for (int ai = 0; ai < 2; ++ai)
#pragma unroll
            for (int m = 0; m < 4; ++m) {
                const int row = row0 + ai * HALF + m * 16;
                const f32x4 s0 = *(const f32x4*)(qss + (size_t)row * 8), s1 = *(const f32x4*)(qss + (size_t)row * 8 + 4);
                const float r = 1.0f / sqrtf(((s0[0] + s0[1]) + (s0[2] + s0[3]) + (s1[0] + s1[1]) + (s1[2] + s1[3])) * (1.0f / 512.0f) + 1e-6f);
#pragma unroll
                for (int bj = 0; bj < 2; ++bj) {
                    const int c32 = u.pn * 8 + bj * 4 + wc, gt = c32 % 6;
                    f32x4 v[2] = {acc[ai][bj][m][0] * r, acc[ai][bj][m][1] * r};
                    if (gt >= 4) {
                        const int pos = gt == 4 ? (row >> 6) : (row & 63);
#pragma unroll
                        for (int n = 0; n < 2; ++n) {
                            const f32x4 cs = *(const f32x4*)(rope + (size_t)(pos * 16 + 4 * fq + 2 * n) * 2);
                            const float a0 = v[n][0], b0 = v[n][1], a1 = v[n][2], b1 = v[n][3];
                            v[n][0] = a0 * cs[0] - b0 * cs[1]; v[n][1] = a0 * cs[1] + b0 * cs[0];
                            v[n][2] = a1 * cs[2] - b1 * cs[3]; v[n][3] = a1 * cs[3] + b1 * cs[2];
                        }
                    }
                    *(u32x4*)(Q + (size_t)row * 3072 + c32 * 32 + 8 * fq) = pack8(v[0], v[1]);
                }
            }
    }
};
struct EpiKVUp {
    static constexpr bool PERM = true, AFTER_DRAIN = false;
    bf16_t* KV; const float* kvss;
    __device__ __forceinline__ void operator()(const f32x4 (&acc)[2][2][4][2], const Unit& u, int wr, int wc, int fr, int fq) const {
        const int row0 = u.pm * BM + wr * 64 + fr, col0 = u.pn * BM + wc * 32 + 8 * fq;
#pragma unroll
        for (int ai = 0; ai < 2; ++ai)
#pragma unroll
            for (int m = 0; m < 4; ++m) {
                const int row = row0 + ai * HALF + m * 16;
                const f32x4 s0 = *(const f32x4*)(kvss + (size_t)row * 8), s1 = *(const f32x4*)(kvss + (size_t)row * 8 + 4);
                const float r = 1.0f / sqrtf(((s0[0] + s0[1]) + (s0[2] + s0[3]) + (s1[0] + s1[1]) + (s1[2] + s1[3])) * (1.0f / 512.0f) + 1e-6f);
#pragma unroll
                for (int bj = 0; bj < 2; ++bj) *(u32x4*)(KV + (size_t)row * 4096 + col0 + bj * HALF) = pack8(acc[ai][bj][m][0] * r, acc[ai][bj][m][1] * r);
            }
    }
};
template <int PASS> struct EpiMerge {
    static constexpr bool PERM = true, AFTER_DRAIN = false;
    const bf16_t* gates; float* T; bf16_t* Y;
    __device__ __forceinline__ void operator()(const f32x4 (&acc)[2][2][4][2], const Unit& u, int wr, int wc, int fr, int fq) const {
        const int row0 = u.pm * BM + wr * 64 + fr, col0 = u.pn * BM + wc * 32 + 8 * fq;
#pragma unroll
        for (int ai = 0; ai < 2; ++ai)
#pragma unroll
            for (int m = 0; m < 4; ++m) {
                const int row = row0 + ai * HALF + m * 16;
#pragma unroll
                for (int bj = 0; bj < 2; ++bj) {
                    const int col = col0 + bj * HALF;
                    const u32x4 g = *(const u32x4*)(gates + (size_t)row * 4096 + PASS * 2048 + col);
                    f32x4 g0, g1;
                    g0[0] = __builtin_bit_cast(float, g.x << 16); g0[1] = __builtin_bit_cast(float, g.x & 0xffff0000u); g0[2] = __builtin_bit_cast(float, g.y << 16); g0[3] = __builtin_bit_cast(float, g.y & 0xffff0000u);
                    g1[0] = __builtin_bit_cast(float, g.z << 16); g1[1] = __builtin_bit_cast(float, g.z & 0xffff0000u); g1[2] = __builtin_bit_cast(float, g.w << 16); g1[3] = __builtin_bit_cast(float, g.w & 0xffff0000u);
                    float* tp = T + (size_t)row * 2048 + col;
                    if (PASS == 0) { *(f32x4*)tp = g0 * acc[ai][bj][m][0]; *(f32x4*)(tp + 4) = g1 * acc[ai][bj][m][1]; }
                    else { const f32x4 t0 = *(const f32x4*)tp, t1 = *(const f32x4*)(tp + 4);
                        *(u32x4*)(Y + (size_t)row * 2048 + col) = pack8(t0 + g0 * acc[ai][bj][m][0], t1 + g1 * acc[ai][bj][m][1]); }
                }
            }
    }
};
struct InProjOrder {
    StaticOrder base; int G, c;
    __host__ __device__ void init(int G_, int c_) { base.init(8192, 8448, G_, c_); G = G_; c = c_; }
    __host__ __device__ bool next(int i, Unit& u) const {
        if (base.next(i, u)) return true;
        const long L = (long)i * G + c - base.nwg; if (L < 0 || L >= 3) return false;
        u.pm = 32; u.pn = L == 0 ? 2 : (L == 1 ? 3 : 32); return true;
    }
    __device__ __forceinline__ void a_ready(const Unit&) const {}
    __device__ __forceinline__ void done(const Unit&) const {}
};

template <class Epi, class Sched, bool ALIGN_EPI = false, bool SP2 = false>
__device__ __forceinline__ void gemm_phase(PG8_LAS unsigned char* lds, const Gemm g, const Sched& S, const Epi& E, const int tid) {
    const int wid = __builtin_amdgcn_readfirstlane(tid >> 6), lane = tid & 63, wr = wid >> 2, wc = wid & 3, fr = lane & 15, fq = lane >> 4;
    const int K = g.K, nt = K / BK;
    unsigned voffA[2], voffB[2];
#pragma unroll
    for (int i = 0; i < 2; ++i) { int R, C; stage_rc(tid * 16 + i * 8192, R, C); const int Rb = Epi::PERM ? ((R & ~31) + perm32(R & 31)) : R;
        voffA[i] = (unsigned)(R * K + C) * 2u; voffB[i] = (unsigned)(Rb * K + C) * 2u; }
    const size_t kstep = (size_t)(BK * 2);
    const size_t hstep = (size_t)HALF * K * 2;
    const size_t tstep = 2 * hstep;
    const unsigned ldsw = (unsigned)wid * 1024u;
    const int aoff = lds_byte(wr * 64 + fr, fq * 8), boff = lds_byte(wc * 32 + fr, fq * 8);
#define PG8_SA(b, h) (((b) * 2 + (h)) * HTB)
#define PG8_SB(b, h) ((4 + (b) * 2 + (h)) * HTB)
#define PG8_STAGE(bufoff, gbase, voff) do { _Pragma("unroll") for (int _i = 0; _i < 2; ++_i) \
        __builtin_amdgcn_global_load_lds((const unsigned*)((const char*)(gbase) + (voff)[_i]), (PG8_LAS unsigned*)(lds + (bufoff) + ldsw + _i * 8192), 16, 0, 0); } while (0)
#define PG8_LDA(dst, b, h) do { _Pragma("unroll") for (int m = 0; m < 4; ++m) _Pragma("unroll") for (int k = 0; k < 2; ++k) dst[m][k] = *(const PG8_LAS bf16x8*)(lds + PG8_SA(b, h) + aoff + m * 2048 + k * 1024); } while (0)
#define PG8_LDB(dst, b, h) do { _Pragma("unroll") for (int n = 0; n < 2; ++n) _Pragma("unroll") for (int k = 0; k < 2; ++k) dst[n][k] = *(const PG8_LAS bf16x8*)(lds + PG8_SB(b, h) + boff + n * 2048 + k * 1024); } while (0)
#define PG8_MMA(ai, bj, At, Bt) do { __builtin_amdgcn_s_setprio(1); _Pragma("unroll") for (int m = 0; m < 4; ++m) _Pragma("unroll") for (int n = 0; n < 2; ++n) _Pragma("unroll") for (int k = 0; k < 2; ++k) \
        acc[ai][bj][m][n] = __builtin_amdgcn_mfma_f32_16x16x32_bf16(Bt[n][k], At[m][k], acc[ai][bj][m][n], 0, 0, 0); __builtin_amdgcn_s_setprio(0); } while (0)
#define PG8_WAIT_V(n) asm volatile("s_waitcnt vmcnt(" #n ")" ::: "memory")
#define PG8_WAIT_L(n) asm volatile("s_waitcnt lgkmcnt(" #n ")" ::: "memory")
#define PG8_BAR __builtin_amdgcn_s_barrier()
#define PG8_SCHED __builtin_amdgcn_sched_barrier(0)
    Unit cur, nxt; int ui = 0;
    if (!S.next(0, cur)) return;
    f32x4 acc[2][2][4][2];
#pragma unroll
    for (int a = 0; a < 2; ++a)
#pragma unroll
        for (int b = 0; b < 2; ++b)
#pragma unroll
            for (int m = 0; m < 4; ++m)
#pragma unroll
                for (int n = 0; n < 2; ++n) acc[a][b][m][n] = (f32x4){0.f, 0.f, 0.f, 0.f};
    bf16x8 At[4][2], B0[2][2], B1[2][2];
    const char* cA = (const char*)g.A + (size_t)cur.pm * tstep; const char* cB = (const char*)g.Bt + (size_t)cur.pn * tstep;
    S.a_ready(cur);
    if constexpr (SP2) {
        PG8_STAGE(PG8_SB(0, 0), cB, voffB); PG8_STAGE(PG8_SB(0, 1), cB + hstep, voffB); PG8_STAGE(PG8_SA(0, 0), cA, voffA); PG8_STAGE(PG8_SA(0, 1), cA + hstep, voffA);
        if (wr == 1) PG8_BAR;
        PG8_WAIT_V(2); PG8_BAR;
        PG8_STAGE(PG8_SB(1, 0), cB + kstep, voffB); PG8_STAGE(PG8_SA(1, 0), cA + kstep, voffA); PG8_STAGE(PG8_SB(1, 1), cB + hstep + kstep, voffB);
        PG8_WAIT_V(6); PG8_BAR;
    } else {
        PG8_STAGE(PG8_SB(0, 0), cB, voffB); PG8_STAGE(PG8_SA(0, 0), cA, voffA); PG8_STAGE(PG8_SB(0, 1), cB + hstep, voffB); PG8_STAGE(PG8_SA(0, 1), cA + hstep, voffA);
        if (wr == 1) PG8_BAR;
        PG8_WAIT_V(4); PG8_BAR;
        PG8_STAGE(PG8_SB(1, 0), cB + kstep, voffB); PG8_STAGE(PG8_SA(1, 0), cA + kstep, voffA); PG8_STAGE(PG8_SB(1, 1), cB + hstep + kstep, voffB);
        PG8_WAIT_V(6); PG8_BAR;
    }
    for (;;) {
        const bool has_next = S.next(ui + 1, nxt);
        const char* nA = has_next ? (const char*)g.A + (size_t)nxt.pm * tstep : cA; const char* nB = has_next ? (const char*)g.Bt + (size_t)nxt.pn * tstep : cB;
        for (int t = 0; t < nt; t += 2) {
            const bool last = (t == nt - 2);
            const char* a1 = cA + (size_t)(t + 1) * kstep;
            const char* a2 = last ? nA : cA + (size_t)(t + 2) * kstep; const char* b2 = last ? nB : cB + (size_t)(t + 2) * kstep;
            const char* a3 = a2 + kstep; const char* b3 = b2 + kstep;
            if (last && has_next) S.a_ready(nxt);
            if constexpr (SP2) {
            PG8_LDB(B0, 0, 0); PG8_LDB(B1, 0, 1); PG8_SCHED; PG8_LDA(At, 0, 0); PG8_STAGE(PG8_SA(1, 1), a1 + hstep, voffA);
            PG8_WAIT_V(8); PG8_WAIT_L(0); PG8_BAR; PG8_MMA(0, 0, At, B0); PG8_MMA(0, 1, At, B1); PG8_BAR; PG8_SCHED;
            PG8_LDA(At, 0, 1); PG8_STAGE(PG8_SB(0, 0), b2, voffB); PG8_STAGE(PG8_SB(0, 1), b2 + hstep, voffB); PG8_STAGE(PG8_SA(0, 0), a2, voffA);
            PG8_WAIT_V(8); PG8_WAIT_L(0); PG8_BAR; PG8_MMA(1, 0, At, B0); PG8_MMA(1, 1, At, B1); PG8_BAR; PG8_SCHED;
            PG8_LDB(B0, 1, 0); PG8_LDB(B1, 1, 1); PG8_SCHED; PG8_LDA(At, 1, 0); PG8_STAGE(PG8_SA(0, 1), a2 + hstep, voffA);
            PG8_WAIT_V(8); PG8_WAIT_L(0); PG8_BAR; PG8_MMA(0, 0, At, B0); PG8_MMA(0, 1, At, B1); PG8_BAR; PG8_SCHED;
            PG8_LDA(At, 1, 1); PG8_STAGE(PG8_SB(1, 0), b3, voffB); PG8_STAGE(PG8_SB(1, 1), b3 + hstep, voffB); PG8_STAGE(PG8_SA(1, 0), a3, voffA);
            PG8_WAIT_V(8); PG8_WAIT_L(0); PG8_BAR; PG8_MMA(1, 0, At, B0); PG8_MMA(1, 1, At, B1); PG8_BAR; PG8_SCHED;
            } else {
            PG8_LDB(B0, 0, 0); PG8_SCHED; PG8_LDA(At, 0, 0); PG8_STAGE(PG8_SA(1, 1), a1 + hstep, voffA);
            PG8_WAIT_L(8); PG8_BAR; PG8_WAIT_L(0); PG8_MMA(0, 0, At, B0); PG8_BAR; PG8_SCHED;
            PG8_LDB(B1, 0, 1); PG8_STAGE(PG8_SB(0, 0), b2, voffB);
            PG8_BAR; PG8_WAIT_L(0); PG8_MMA(0, 1, At, B1); PG8_BAR;
            PG8_LDA(At, 0, 1); PG8_STAGE(PG8_SA(0, 0), a2, voffA);
            PG8_BAR; PG8_WAIT_L(0); PG8_MMA(1, 0, At, B0); PG8_BAR; PG8_SCHED;
            PG8_STAGE(PG8_SB(0, 1), b2 + hstep, voffB);
            PG8_WAIT_V(6); PG8_BAR; PG8_MMA(1, 1, At, B1); PG8_BAR;
            PG8_LDB(B0, 1, 0); PG8_SCHED; PG8_LDA(At, 1, 0); PG8_STAGE(PG8_SA(0, 1), a2 + hstep, voffA);
            PG8_WAIT_L(8); PG8_BAR; PG8_WAIT_L(0); PG8_MMA(0, 0, At, B0); PG8_BAR; PG8_SCHED;
            PG8_LDB(B1, 1, 1); PG8_STAGE(PG8_SB(1, 0), b3, voffB);
            PG8_BAR; PG8_WAIT_L(0); PG8_MMA(0, 1, At, B1); PG8_BAR;
            PG8_LDA(At, 1, 1); PG8_STAGE(PG8_SA(1, 0), a3, voffA);
            PG8_BAR; PG8_WAIT_L(0); PG8_MMA(1, 0, At, B0); PG8_BAR; PG8_SCHED;
            PG8_STAGE(PG8_SB(1, 1), b3 + hstep, voffB);
            PG8_WAIT_V(6); PG8_BAR; PG8_MMA(1, 1, At, B1); PG8_BAR;
            }
        }
        if constexpr (ALIGN_EPI) { if (wr == 0) PG8_BAR; }
        if constexpr (!Epi::AFTER_DRAIN) { E(acc, cur, wr, wc, fr, fq); S.done(cur); }
        if (!has_next) break;
#pragma unroll
        for (int a = 0; a < 2; ++a)
#pragma unroll
            for (int b = 0; b < 2; ++b)
#pragma unroll
                for (int m = 0; m < 4; ++m)
#pragma unroll
                    for (int n = 0; n < 2; ++n) acc[a][b][m][n] = (f32x4){0.f, 0.f, 0.f, 0.f};
        cur = nxt; cA = nA; cB = nB; ++ui;
        if constexpr (ALIGN_EPI) { if (wr == 1) PG8_BAR; }
    }
    PG8_WAIT_V(0);
    if constexpr (!ALIGN_EPI) { if (wr == 0) PG8_BAR; }
    PG8_BAR;
    if constexpr (Epi::AFTER_DRAIN) { E.fused(acc, cur, wr, wc, fr, fq, lds, wid, lane); S.done(cur); }
#undef PG8_SA
#undef PG8_SB
#undef PG8_STAGE
#undef PG8_LDA
#undef PG8_LDB
#undef PG8_MMA
#undef PG8_WAIT_V
#undef PG8_WAIT_L
#undef PG8_BAR
#undef PG8_SCHED
}
}

namespace att {
using bf16x8 = __attribute__((ext_vector_type(8))) short;
using s16x4  = __attribute__((ext_vector_type(4))) short;
using f32x16 = __attribute__((ext_vector_type(16))) float;
using u32x4  = __attribute__((ext_vector_type(4))) unsigned;
constexpr int NW = 8, QBLK = 32, KVBLK = 64;
#ifndef ATT_NQREG
#define ATT_NQREG 3
#endif
#ifndef QKT_PIN
#define QKT_PIN 1
#endif
#ifndef QKT_PIN_MASK
#define QKT_PIN_MASK 3
#endif
constexpr int NQREG = ATT_NQREG, NQLDS = 12 - NQREG;
constexpr float SCALE = 0.07216878364870322f;
constexpr float THR = 8.f;
constexpr int LDQ = 3072, LDK = 4096, LDR = 64, LDO = 2048;
constexpr int SHM_V = KVBLK * 128 * 2, SHM_K = KVBLK * 128 * 2, SHM_R = KVBLK * 64 * 2;
constexpr int OFF_V = 0, OFF_K = 2 * SHM_V, OFF_R = OFF_K + 2 * SHM_K, OFF_WS = OFF_R + 2 * SHM_R, OFF_QR = OFF_WS + NW * 64 * 4, SHM_ATTN = OFF_QR + NW * NQLDS * 1024;
#define KSWZ(row, colB) ((row) * 256 + ((colB) ^ (((row) & 7) << 4)))
#define RSWZ(row, ch) ((row) * 128 + ((((ch) ^ (((row) >> 1) & 7))) << 4))
#define SBAR() __builtin_amdgcn_sched_barrier(0)
__device__ __forceinline__ int crow(int r, int hi) { return (r & 3) + 8 * (r >> 2) + 4 * hi; }
typedef float f32x2_t __attribute__((ext_vector_type(2))); typedef __bf16 bf16x2_t __attribute__((ext_vector_type(2)));
__device__ __forceinline__ unsigned cvtpk(float lo, float hi) { f32x2_t v = {lo, hi}; bf16x2_t b = __builtin_convertvector(v, bf16x2_t); return __builtin_bit_cast(unsigned, b); }

__device__ __forceinline__ void partialSM(f32x16& p0, f32x16& p1, float& m_reg, float& mn, float& alpha) {
  constexpr float C = SCALE * 1.4426950408889634f;
  float pmax = p0[0];
#pragma unroll
  for (int r = 1; r < 16; ++r) pmax = fmaxf(pmax, p0[r]);
#pragma unroll
  for (int r = 0; r < 16; ++r) pmax = fmaxf(pmax, p1[r]);
  { auto rr = __builtin_amdgcn_permlane32_swap(__float_as_uint(pmax), __float_as_uint(pmax), false, false);
    pmax = fmaxf(__uint_as_float(rr[0]), __uint_as_float(rr[1])); }
  if (__builtin_expect(__all(pmax - m_reg <= THR / SCALE), 1)) { mn = m_reg; alpha = 1.f; }
  else { mn = fmaxf(m_reg, pmax); alpha = __builtin_amdgcn_exp2f((m_reg - mn) * C); m_reg = mn; }
  float mnC = -mn * C;
#pragma unroll
  for (int r = 0; r < 16; ++r) p0[r] = fmaf(p0[r], C, mnC);
#pragma unroll
  for (int r = 0; r < 16; ++r) p1[r] = fmaf(p1[r], C, mnC);
#pragma unroll
  for (int r = 0; r < 16; ++r) p0[r] = __builtin_amdgcn_exp2f(p0[r]);
}
__device__ __forceinline__ void finishSM(f32x16& p0, f32x16& p1, float alpha, float& l_reg, bf16x8& pa0, bf16x8& pa1, bf16x8& pa2, bf16x8& pa3) {
#pragma unroll
  for (int r = 0; r < 16; ++r) p1[r] = __builtin_amdgcn_exp2f(p1[r]);
  float ps = 0;
#pragma unroll
  for (int r = 0; r < 16; ++r) ps += p0[r];
#pragma unroll
  for (int r = 0; r < 16; ++r) ps += p1[r];
  { auto rr = __builtin_amdgcn_permlane32_swap(__float_as_uint(ps), __float_as_uint(ps), false, false);
    ps = __uint_as_float(rr[0]) + __uint_as_float(rr[1]); }
  l_reg = l_reg * alpha + ps;
#define PK4(P, BASE, OUT) do { unsigned a0 = cvtpk(P[BASE + 0], P[BASE + 1]), a1 = cvtpk(P[BASE + 2], P[BASE + 3]);   \
    unsigned b0 = cvtpk(P[BASE + 4], P[BASE + 5]), b1 = cvtpk(P[BASE + 6], P[BASE + 7]);                              \
    auto r0 = __builtin_amdgcn_permlane32_swap(a0, b0, false, false); auto r1 = __builtin_amdgcn_permlane32_swap(a1, b1, false, false); \
    u32x4 w = {r0[0], r1[0], r0[1], r1[1]}; OUT = *reinterpret_cast<bf16x8*>(&w); } while (0)
  PK4(p0, 0, pa0); PK4(p0, 8, pa1); PK4(p1, 0, pa2); PK4(p1, 8, pa3);
#undef PK4
}
typedef LAS char* lp_t; typedef const LAS char* clp_t;
__device__ __forceinline__ void qkt(f32x16& p0, f32x16& p1, clp_t Ks, clp_t Rs, const bf16x8* qr, clp_t Qr, int r32, int hi) {
  p0 = f32x16{}; p1 = f32x16{};
#pragma unroll
  for (int d0 = 0; d0 < 8; ++d0) { int cb = (d0 * 16 + hi * 8) * 2;
    bf16x8 b0 = *(const LAS bf16x8*)(Ks + KSWZ(r32, cb));
    bf16x8 b1 = *(const LAS bf16x8*)(Ks + KSWZ(32 + r32, cb));
    bf16x8 qv; if (d0 < NQREG) qv = qr[d0]; else qv = *(const LAS bf16x8*)(Qr + (d0 - NQREG) * 1024);
    p0 = __builtin_amdgcn_mfma_f32_32x32x16_bf16(b0, qv, p0, 0, 0, 0);
    p1 = __builtin_amdgcn_mfma_f32_32x32x16_bf16(b1, qv, p1, 0, 0, 0);
    if (QKT_PIN && (d0 & (QKT_PIN_MASK)) == (QKT_PIN_MASK)) SBAR(); }
#pragma unroll
  for (int d0 = 0; d0 < 4; ++d0) { int ch = d0 * 2 + hi;
    bf16x8 b0 = *(const LAS bf16x8*)(Rs + RSWZ(r32, ch));
    bf16x8 b1 = *(const LAS bf16x8*)(Rs + RSWZ(32 + r32, ch));
    bf16x8 qv; if (8 + d0 < NQREG) qv = qr[8 + d0]; else qv = *(const LAS bf16x8*)(Qr + (8 + d0 - NQREG) * 1024);
    p0 = __builtin_amdgcn_mfma_f32_32x32x16_bf16(b0, qv, p0, 0, 0, 0);
    p1 = __builtin_amdgcn_mfma_f32_32x32x16_bf16(b1, qv, p1, 0, 0, 0); }
}
__device__ __forceinline__ int v_st(int k, int c) { const int kk = (k & ~0xC) | ((k & 4) << 1) | ((k & 8) >> 1); return ((kk >> 3) * 4 + (c >> 5)) * 512 + ((kk & 7) * 32 + (c & 31)) * 2; }
__device__ __forceinline__ int v_rd_base(int lane) { return ((lane & 3) << 3) | (((lane >> 2) & 3) << 6) | (((lane >> 4) & 1) << 5) | (((lane >> 5) & 1) << 8); }
constexpr int v_rd_off(int d0, int ks, int half) { return d0 * 512 + ks * 4096 + half * 2048; }
template <int OFF> __device__ __forceinline__ s16x4 tr_read(int vb) {
  s16x4 r; asm volatile("ds_read_b64_tr_b16 %0, %1 offset:%2" : "=&v"(r) : "v"(vb), "i"(OFF) : "memory"); return r;
}
template <int D0> __device__ __forceinline__ void pv_one(f32x16& od, int vb, bf16x8 pa0, bf16x8 pa1, bf16x8 pa2, bf16x8 pa3) {
  const s16x4 l0 = tr_read<v_rd_off(D0, 0, 0)>(vb), h0 = tr_read<v_rd_off(D0, 0, 1)>(vb), l1 = tr_read<v_rd_off(D0, 1, 0)>(vb), h1 = tr_read<v_rd_off(D0, 1, 1)>(vb);
  const s16x4 l2 = tr_read<v_rd_off(D0, 2, 0)>(vb), h2 = tr_read<v_rd_off(D0, 2, 1)>(vb), l3 = tr_read<v_rd_off(D0, 3, 0)>(vb), h3 = tr_read<v_rd_off(D0, 3, 1)>(vb);
  asm volatile("s_waitcnt lgkmcnt(0)" ::: "memory"); SBAR();
#define PK(L, H) (bf16x8){L[0], L[1], L[2], L[3], H[0], H[1], H[2], H[3]}
  od = __builtin_amdgcn_mfma_f32_32x32x16_bf16(pa0, PK(l0, h0), od, 0, 0, 0);
  od = __builtin_amdgcn_mfma_f32_32x32x16_bf16(pa1, PK(l1, h1), od, 0, 0, 0);
  od = __builtin_amdgcn_mfma_f32_32x32x16_bf16(pa2, PK(l2, h2), od, 0, 0, 0);
  od = __builtin_amdgcn_mfma_f32_32x32x16_bf16(pa3, PK(l3, h3), od, 0, 0, 0);
#undef PK
}
__device__ __forceinline__ void pv_d0(f32x16* o, int vb, bf16x8 pa0, bf16x8 pa1, bf16x8 pa2, bf16x8 pa3) {
  pv_one<0>(o[0], vb, pa0, pa1, pa2, pa3); pv_one<1>(o[1], vb, pa0, pa1, pa2, pa3); pv_one<2>(o[2], vb, pa0, pa1, pa2, pa3); pv_one<3>(o[3], vb, pa0, pa1, pa2, pa3);
}
__device__ __forceinline__ void attn_unit(const unsigned short* __restrict__ Qb, const unsigned short* __restrict__ Kbase0, const unsigned short* __restrict__ Kn,
                                          const unsigned short* __restrict__ Kr, unsigned short* __restrict__ Ob, int seq, LAS char* lds, const int tid) {
  const int wid = __builtin_amdgcn_readfirstlane(tid >> 6), lane = tid & 63, r32 = lane & 31, hi = lane >> 5;
  lp_t V_lds = lds + OFF_V; lp_t K_lds = lds + OFF_K; lp_t R_lds = lds + OFF_R;
  LAS float* ws = (LAS float*)(lds + OFF_WS) + wid * 64; LAS float* li_l = ws; LAS float* al_l = ws + 32;
  float m_reg = -1e30f, l_reg = 0; f32x16 o[4] = {}; bf16x8 qr[NQREG > 0 ? NQREG : 1];
  const unsigned short* Qw = Qb + (long)(wid * QBLK + r32) * LDQ + hi * 8;
#pragma unroll
  for (int d0 = 0; d0 < NQREG; ++d0) qr[d0] = *reinterpret_cast<const bf16x8*>(Qw + d0 * 16);
  lp_t Qr = lds + OFF_QR + wid * (NQLDS * 1024) + (hi * 32 + r32) * 16;
#pragma unroll
  for (int d0 = NQREG; d0 < 12; ++d0) *(LAS bf16x8*)(Qr + (d0 - NQREG) * 1024) = *reinterpret_cast<const bf16x8*>(Qw + d0 * 16);
  const int sr = tid >> 4, sc = (tid & 15) * 8, vst0 = v_st(sr, sc), vst1 = v_st(32 + sr, sc);
  const int rk = tid >> 3, rch = tid & 7, rst = RSWZ(rk, rch);
  const int vb0 = (int)(unsigned)(uintptr_t)V_lds + v_rd_base(lane);
  bf16x8 vs0, vs1, ks0, ks1, rs0;
  const __amdgpu_buffer_rsrc_t srdKV = __builtin_amdgcn_make_buffer_rsrc((void*)Kn, (short)0, (int)(((long)seq * LDK - (Kn - Kbase0)) * 2), 0x00020000);
  const __amdgpu_buffer_rsrc_t srdR = __builtin_amdgcn_make_buffer_rsrc((void*)Kr, (short)0, (int)((long)seq * LDR * 2), 0x00020000);
  const int voffKV = (sr * LDK + sc) * 2, voffR = (rk * LDR + rch * 8) * 2;
#define BLD(srd, vo, so) __builtin_bit_cast(bf16x8, __builtin_amdgcn_raw_buffer_load_b128(srd, vo, so, 0))
#define SLOAD(k0) do { const int so_ = __builtin_amdgcn_readfirstlane((k0) * LDK * 2); \
    vs0 = BLD(srdKV, voffKV + 256, so_); vs1 = BLD(srdKV, voffKV + 256, so_ + 32 * LDK * 2); \
    ks0 = BLD(srdKV, voffKV, so_); ks1 = BLD(srdKV, voffKV, so_ + 32 * LDK * 2); \
    rs0 = BLD(srdR, voffR, __builtin_amdgcn_readfirstlane((k0) * LDR * 2)); } while (0)
#define SWRITE(b) do { *(LAS bf16x8*)(V_lds + (b) * SHM_V + vst0) = vs0; *(LAS bf16x8*)(V_lds + (b) * SHM_V + vst1) = vs1; int kc = sc * 2; \
    *(LAS bf16x8*)(K_lds + (b) * SHM_K + KSWZ(sr, kc)) = ks0; *(LAS bf16x8*)(K_lds + (b) * SHM_K + KSWZ(32 + sr, kc)) = ks1; \
    *(LAS bf16x8*)(R_lds + (b) * SHM_R + rst) = rs0; } while (0)
#define SWAIT() asm volatile("s_waitcnt vmcnt(0)" ::: "memory")
#define RESC(a) do { if (__any((a) < 1.f)) { if (hi == 0) al_l[r32] = (a); asm volatile("s_waitcnt lgkmcnt(0)" ::: "memory"); \
    _Pragma("unroll") for (int d = 0; d < 4; ++d) _Pragma("unroll") for (int r = 0; r < 16; ++r) o[d][r] *= al_l[crow(r, hi)]; } } while (0)
  f32x16 pA0, pA1, pB0, pB1; float mnA, mnB, alA, alB; bf16x8 pa0, pa1, pa2, pa3; const int NT = seq / KVBLK;
  SLOAD(0); SWAIT(); SWRITE(0); __syncthreads();
  qkt(pA0, pA1, K_lds, R_lds, qr, Qr, r32, hi); partialSM(pA0, pA1, m_reg, mnA, alA);
  SLOAD(KVBLK);
  SWAIT(); SWRITE(1); __syncthreads();
  for (int j = 1; j + 1 < NT; j += 2) {
    SBAR(); qkt(pB0, pB1, K_lds + SHM_K, R_lds + SHM_R, qr, Qr, r32, hi);
    finishSM(pA0, pA1, alA, l_reg, pa0, pa1, pa2, pa3); SBAR();
    SLOAD((j + 1) * KVBLK); SBAR();
    pv_d0(o, vb0, pa0, pa1, pa2, pa3); partialSM(pB0, pB1, m_reg, mnB, alB);
    __syncthreads(); SWAIT(); SWRITE(0);
    RESC(alB); __syncthreads();
    SBAR(); qkt(pA0, pA1, K_lds, R_lds, qr, Qr, r32, hi);
    finishSM(pB0, pB1, alB, l_reg, pa0, pa1, pa2, pa3); SBAR();
    SLOAD((j + 2) * KVBLK); SBAR();
    pv_d0(o, vb0 + SHM_V, pa0, pa1, pa2, pa3); partialSM(pA0, pA1, m_reg, mnA, alA);
    __syncthreads(); SWAIT(); SWRITE(1);
    RESC(alA); __syncthreads();
  }
  SBAR(); qkt(pB0, pB1, K_lds + SHM_K, R_lds + SHM_R, qr, Qr, r32, hi);
  finishSM(pA0, pA1, alA, l_reg, pa0, pa1, pa2, pa3); SBAR();
  pv_d0(o, vb0, pa0, pa1, pa2, pa3); partialSM(pB0, pB1, m_reg, mnB, alB);
  __syncthreads(); RESC(alB);
  finishSM(pB0, pB1, alB, l_reg, pa0, pa1, pa2, pa3); SBAR();
  pv_d0(o, vb0 + SHM_V, pa0, pa1, pa2, pa3);
  if (hi == 0) li_l[r32] = l_reg; asm volatile("s_waitcnt lgkmcnt(0)" ::: "memory");
  float rli[16];
#pragma unroll
  for (int r = 0; r < 16; ++r) rli[r] = __builtin_amdgcn_rcpf(li_l[crow(r, hi)]);
  unsigned short* Ow = Ob + (long)(wid * QBLK) * LDO;
#pragma unroll
  for (int r = 0; r < 16; ++r) { int orow = crow(r, hi);
#pragma unroll
    for (int d0 = 0; d0 < 4; ++d0) Ow[(long)orow * LDO + d0 * 32 + r32] = (unsigned short)(cvtpk(o[d0][r] * rli[r], 0.f) & 0xffffu); }
  __syncthreads();
#undef SLOAD
#undef BLD
#undef SWRITE
#undef SWAIT
#undef RESC
}
#undef KSWZ
#undef RSWZ
#undef SBAR
}

#define HD __device__ __forceinline__
#if defined(__HIPCC__)
typedef float cplx __attribute__((ext_vector_type(2)));
HD cplx mkc(float a, float b) { cplx r; r.x = a; r.y = b; return r; }
#endif
constexpr int FFT_M = 8192;
constexpr int FFT_BUF = 8704;
HD int fpad(int i) { return i + 2 * (i >> 5); }
HD int rev13(unsigned k) {
#if defined(__HIP_DEVICE_COMPILE__)
    return (int)(__brev(k) >> 19);
#else
    unsigned r = 0; for (int b = 0; b < 13; ++b) r |= ((k >> b) & 1u) << (12 - b); return (int)r;
#endif
}
HD void cs_rev(float rev, float& c, float& s) {
#if defined(__HIP_DEVICE_COMPILE__)
    c = __builtin_amdgcn_cosf(rev); s = __builtin_amdgcn_sinf(rev);
#else
    c = (float)cos(6.283185307179586 * (double)rev); s = (float)sin(6.283185307179586 * (double)rev);
#endif
}
HD cplx cmulf(cplx a, cplx b) { return mkc(a.x * b.x - a.y * b.y, a.x * b.y + a.y * b.x); }

template <int SHIFT, int S0, bool INV, typename BufT>
HD void fft_pass16(int tid, BufT buf) {
#if defined(__HIP_DEVICE_COMPILE__)
    asm volatile("" : "+v"(tid));
#endif
    const int lo = tid & ((1 << SHIFT) - 1);
    const int base = ((tid >> SHIFT) << (SHIFT + 4)) | lo;
    cplx r[16];
#pragma unroll
    for (int j = 0; j < 16; ++j) r[j] = buf[fpad(base + (j << SHIFT))];
    if (!INV) {
#pragma unroll
        for (int ss = 0; ss < 4; ++ss) {
            const int hj = 8 >> ss;
#pragma unroll
            for (int j = 0; j < 16; ++j) {
                if (j & hj) continue;
                const int e = (lo + ((j & (hj - 1)) << SHIFT)) << (S0 + ss);
                float c, s; cs_rev((float)e * (1.0f / FFT_M), c, s);
                const cplx a = r[j], b = r[j + hj];
                r[j] = mkc(a.x + b.x, a.y + b.y);
                const cplx d = mkc(a.x - b.x, a.y - b.y);
                r[j + hj] = cmulf(d, mkc(c, -s));
            }
        }
    } else {
#pragma unroll
        for (int ss = 3; ss >= 0; --ss) {
            const int hj = 8 >> ss;
#pragma unroll
            for (int j = 0; j < 16; ++j) {
                if (j & hj) continue;
                const int e = (lo + ((j & (hj - 1)) << SHIFT)) << (S0 + ss);
                float c, s; cs_rev((float)e * (1.0f / FFT_M), c, s);
                const cplx t = cmulf(r[j + hj], mkc(c, s));
                const cplx a = r[j];
                r[j] = mkc(a.x + t.x, a.y + t.y);
                r[j + hj] = mkc(a.x - t.x, a.y - t.y);
            }
        }
    }
#pragma unroll
    for (int j = 0; j < 16; ++j) buf[fpad(base + (j << SHIFT))] = r[j];
}
template <typename BufT>
HD void fft_pass_last(int tid, BufT buf) {
#pragma unroll
    for (int q = 0; q < 8; ++q) {
        const int i = 2 * (tid + 512 * q), p = fpad(i);
        const cplx a = buf[p], b = buf[p + 1];
        buf[p] = mkc(a.x + b.x, a.y + b.y);
        buf[p + 1] = mkc(a.x - b.x, a.y - b.y);
    }
}
template <typename BufT>
HD void fft_combine(int tid, BufT A, BufT B) {
#if defined(__HIP_DEVICE_COMPILE__)
    asm volatile("" : "+v"(tid));
#endif
#pragma unroll 1
    for (int q = 0; q < 9; ++q) {
        const int k = tid + 512 * q;
        if (k > FFT_M / 2) break;
        const int pk = fpad(rev13((unsigned)k)), pm = fpad(rev13((unsigned)((FFT_M - k) & (FFT_M - 1))));
        const cplx za = A[pk], zb = A[pm], ha = B[pk], hb = B[pm];
        float c, s; cs_rev((float)k * (1.0f / (2 * FFT_M)), c, s);
        const cplx w = mkc(c, -s);
        const cplx Ex = mkc(0.5f * (za.x + zb.x), 0.5f * (za.y - zb.y));
        const cplx Dx = mkc(za.x - zb.x, za.y + zb.y);
        const cplx Ox = mkc(0.5f * Dx.y, -0.5f * Dx.x);
        const cplx Eh = mkc(0.5f * (ha.x + hb.x), 0.5f * (ha.y - hb.y));
        const cplx Dh = mkc(ha.x - hb.x, ha.y + hb.y);
        const cplx Oh = mkc(0.5f * Dh.y, -0.5f * Dh.x);
        const cplx wOx = cmulf(w, Ox), wOh = cmulf(w, Oh);
        const cplx X1 = mkc(Ex.x + wOx.x, Ex.y + wOx.y), X2 = mkc(Ex.x - wOx.x, Ex.y - wOx.y);
        const cplx H1 = mkc(Eh.x + wOh.x, Eh.y + wOh.y), H2 = mkc(Eh.x - wOh.x, Eh.y - wOh.y);
        const cplx Y1 = cmulf(X1, H1), Y2 = cmulf(X2, H2);
        const cplx Ey = mkc(0.5f * (Y1.x + Y2.x), 0.5f * (Y1.y + Y2.y));
        const cplx Dy = mkc(0.5f * (Y1.x - Y2.x), 0.5f * (Y1.y - Y2.y));
        const cplx Oy = cmulf(Dy, mkc(c, s));
        A[pk] = mkc(Ey.x - Oy.y, Ey.y + Oy.x);
        if (k != 0 && k != FFT_M / 2) A[pm] = mkc(Ey.x + Oy.y, -Ey.y + Oy.x);
    }
}
template <typename BufT>
HD void fft_put16(int tid, BufT buf, const float* x16) {
#pragma unroll
    for (int q = 0; q < 8; ++q) {
        buf[fpad(8 * tid + q)] = mkc(x16[2 * q], x16[2 * q + 1]);
        buf[fpad(4096 + 8 * tid + q)] = mkc(0.f, 0.f);
    }
}
template <typename BufT>
HD void fft_get16_mid(int tid, BufT buf, float* y16) {
#pragma unroll
    for (int q = 0; q < 8; ++q) { const cplx f = buf[fpad(2048 + 8 * tid + q)]; y16[2 * q] = f.x; y16[2 * q + 1] = f.y; }
}

typedef LAS cplx* lbuf_t;
__device__ __forceinline__ void fft_fwd2(int tid, lbuf_t A, lbuf_t B) {
    __syncthreads();
    fft_pass16<9, 0, false>(tid, A); __builtin_amdgcn_sched_barrier(0); fft_pass16<9, 0, false>(tid, B); __syncthreads();
    fft_pass16<5, 4, false>(tid, A); __builtin_amdgcn_sched_barrier(0); fft_pass16<5, 4, false>(tid, B); __syncthreads();
    fft_pass16<1, 8, false>(tid, A); __builtin_amdgcn_sched_barrier(0); fft_pass16<1, 8, false>(tid, B); __syncthreads();
    fft_pass_last(tid, A); fft_pass_last(tid, B); __syncthreads();
}
__device__ __forceinline__ void fft_inv1(int tid, lbuf_t A) {
    fft_pass_last(tid, A); __syncthreads();
    fft_pass16<1, 8, true>(tid, A); __syncthreads();
    fft_pass16<5, 4, true>(tid, A); __syncthreads();
    fft_pass16<9, 0, true>(tid, A); __syncthreads();
}
__device__ __forceinline__ void shortconv16(const bf16* hyT, int ch, int tid, const float* conv_w, const float* conv_b, float* out) {
    const bf16* p = hyT + (size_t)ch * 8192 + 16 * tid;
    const v4u a = *(const v4u*)p, b = *(const v4u*)(p + 8);
    float u[18];
    u[0] = tid > 0 ? bf2f(p[-1]) : 0.f; u[17] = tid < 511 ? bf2f(p[16]) : 0.f;
    const unsigned w[8] = {a.x, a.y, a.z, a.w, b.x, b.y, b.z, b.w};
#pragma unroll
    for (int i = 0; i < 8; ++i) { u[1 + 2 * i] = __builtin_bit_cast(float, w[i] << 16); u[2 + 2 * i] = __builtin_bit_cast(float, w[i] & 0xffff0000u); }
    const float w0 = conv_w[ch], w1 = conv_w[3072 + ch], w2 = conv_w[6144 + ch], bb = conv_b[ch];
#pragma unroll
    for (int i = 0; i < 16; ++i) out[i] = w0 * u[i] + w1 * u[i + 1] + w2 * u[i + 2] + bb;
}
__device__ __forceinline__ float block_sum512(float v, LAS float* red, int tid) {
    v = wave_sum(v);
    if ((tid & 63) == 0) red[tid >> 6] = v;
    __syncthreads();
    float s = 0.f;
#pragma unroll
    for (int i = 0; i < 8; ++i) s += red[i];
    __syncthreads();
    return s;
}
__device__ __forceinline__ void hyena_unit(int c, const bf16* hyT, const float* conv_w, const float* conv_b, const float* hfilt, const float* skip, bf16* hyo, LAS unsigned char* lds, const int tid) {
    lbuf_t A = (lbuf_t)lds, B = (lbuf_t)(lds + FFT_BUF * 8);
    LAS float* red = (LAS float*)(lds + 2 * FFT_BUF * 8);
    float v[16], y[16], g[16];
    float ss = 0.f;
    { const float* hp = hfilt + (size_t)c * 8192 + 16 * tid;
#pragma unroll
      for (int i = 0; i < 4; ++i) { const v4f h4 = *(const v4f*)(hp + 4 * i); g[4 * i] = h4[0]; g[4 * i + 1] = h4[1]; g[4 * i + 2] = h4[2]; g[4 * i + 3] = h4[3]; }
#pragma unroll
      for (int i = 0; i < 16; ++i) ss += g[i] * g[i]; }
    fft_put16(tid, B, g);
    shortconv16(hyT, c, tid, conv_w, conv_b, v);
    fft_put16(tid, A, v);
    const float rn0 = (1.0f / sqrtf(block_sum512(ss, red, tid) + 1e-6f)) * (1.0f / FFT_M);
    fft_fwd2(tid, A, B);
    fft_combine(tid, A, B); __syncthreads();
    fft_inv1(tid, A);
    fft_get16_mid(tid, A, y);
    shortconv16(hyT, 1024 + c, tid, conv_w, conv_b, g);
    const float sk0 = skip[c], sk1 = skip[1024 + c];
#pragma unroll
    for (int i = 0; i < 16; ++i) v[i] = g[i] * (y[i] * rn0 + sk0 * v[i]);
    __syncthreads();
    ss = 0.f;
    { const float* hp = hfilt + (size_t)(1024 + c) * 8192 + 16 * tid;
#pragma unroll
      for (int i = 0; i < 4; ++i) { const v4f h4 = *(const v4f*)(hp + 4 * i); g[4 * i] = h4[0]; g[4 * i + 1] = h4[1]; g[4 * i + 2] = h4[2]; g[4 * i + 3] = h4[3]; }
#pragma unroll
      for (int i = 0; i < 16; ++i) ss += g[i] * g[i]; }
    fft_put16(tid, B, g);
    fft_put16(tid, A, v);
    const float rn1 = (1.0f / sqrtf(block_sum512(ss, red, tid) + 1e-6f)) * (1.0f / FFT_M);
    fft_fwd2(tid, A, B);
    fft_combine(tid, A, B); __syncthreads();
    fft_inv1(tid, A);
    fft_get16_mid(tid, A, y);
    shortconv16(hyT, 2048 + c, tid, conv_w, conv_b, g);
    v4u o0, o1;
    float r[16];
#pragma unroll
    for (int i = 0; i < 16; ++i) r[i] = g[i] * (y[i] * rn1 + sk1 * v[i]);
    o0.x = pk2(r[0], r[1]); o0.y = pk2(r[2], r[3]); o0.z = pk2(r[4], r[5]); o0.w = pk2(r[6], r[7]);
    o1.x = pk2(r[8], r[9]); o1.y = pk2(r[10], r[11]); o1.z = pk2(r[12], r[13]); o1.w = pk2(r[14], r[15]);
    bf16* op = hyo + (size_t)c * 8192 + 16 * tid;
    *(v4u*)op = o0; *(v4u*)(op + 8) = o1;
    __syncthreads();
}

template <class ColFn>
__device__ __forceinline__ void cvt_item(const float* W, int K, int N, bf16* WT, int nblk, ColFn col, const float* kscale, LAS float* scr, int item, int lane) {
    const int kb = item / nblk, nb = item % nblk, k0 = 64 * kb, n0 = 32 * nb;
    const int src = col(n0 + (lane & 31));
#pragma unroll 8
    for (int i = 0; i < 32; ++i) { const int kk = 2 * i + (lane >> 5); float val = src >= 0 ? W[(size_t)(k0 + kk) * N + src] : 0.f; if (kscale) val *= kscale[k0 + kk]; scr[kk * 33 + (lane & 31)] = val; }
    LDS_WAIT(); asm volatile("" ::: "memory");
    const int c = lane & 7;
#pragma unroll
    for (int j = 0; j < 4; ++j) { const int n = (lane >> 3) + 8 * j; const LAS float* s = scr + (8 * c) * 33 + n;
        v4u o; o.x = pk2(s[0 * 33], s[1 * 33]); o.y = pk2(s[2 * 33], s[3 * 33]); o.z = pk2(s[4 * 33], s[5 * 33]); o.w = pk2(s[6 * 33], s[7 * 33]);
        *(v4u*)(WT + (size_t)(n0 + n) * K + k0 + 8 * c) = o; }
    LDS_WAIT(); asm volatile("" ::: "memory");
}
struct ColId { __device__ __forceinline__ int operator()(int n) const { return n; } };
struct ColW13 { __device__ __forceinline__ int operator()(int n) const { return ((n & 255) >> 7) * 5632 + (n >> 8) * 128 + (n & 127); } };
__device__ __forceinline__ int rope_src(int j) { const int grp = j >> 5, jj = j & 31; return grp * 32 + (jj & 1) * 16 + (jj >> 1); }
struct ColWin { __device__ __forceinline__ int operator()(int n) const {
    if (n < 1024) return n; if (n < 4096) return 1088 + (n - 1024); if (n < 8192) return 4160 + (n - 4096); if (n < 8256) return 1024 + rope_src(n - 8192); return -1; } };
struct ColWuq { __device__ __forceinline__ int operator()(int n) const { const int h = n / 192, w = n - h * 192; return w < 128 ? n : h * 192 + 128 + rope_src(w - 128); } };

__device__ __forceinline__ void mod_unit(int unit, const float* w_mod, const float* b_mod, float* mods, const LAS float* sc  , LAS float* red  , int tid) {
    const int lane = tid & 63, wv = tid >> 6, col = unit * 64 + lane;
    float a0 = 0.f, a1 = 0.f;
    const float* wp = w_mod + (size_t)(wv * 256) * 18432 + col;
#pragma unroll 16
    for (int k = 0; k < 256; ++k) { const float w = wp[(size_t)k * 18432]; a0 += sc[wv * 256 + k] * w; a1 += sc[2048 + wv * 256 + k] * w; }
    red[(wv * 2 + 0) * 64 + lane] = a0; red[(wv * 2 + 1) * 64 + lane] = a1;
    __syncthreads();
    if (tid < 128) { const int v = tid >> 6; float s = b_mod[col];
#pragma unroll
        for (int w = 0; w < 8; ++w) s += red[(w * 2 + v) * 64 + lane];
        mods[v * 18432 + col] = s; }
    __syncthreads();
}
__device__ __forceinline__ void filter_unit(int unit, const float* w1, const float* b1, const float* w2, const float* b2, const float* w3, const float* freq, float* hfilt, LAS float* Z  , LAS float* H1  , LAS float* H2  , int tid) {
    const int t0 = (unit >> 2) * 64, oq = unit & 3, lane = tid & 63, wv = tid >> 6;
#pragma unroll 1
    for (int idx = tid; idx < 33 * 64; idx += 512) {
        const int i = idx >> 6, t = t0 + (idx & 63); float val;
        if (i == 0) val = (float)t / 8191.0f;
        else { const int b = (i - 1) & 15; const double band = 1e-4 + (double)b * ((15.0 - 1e-4) / 15.0); double rv = band * (double)t * (1.0 / 8192.0); rv -= floor(rv);
               const float ang = 6.283185307179586f * (float)rv; val = i <= 16 ? cosf(ang) : -sinf(ang); }
        Z[idx] = val;
    }
    __syncthreads();
    {   float acc[8];
#pragma unroll
        for (int q = 0; q < 8; ++q) acc[q] = b1[wv * 8 + q];
#pragma unroll 1
        for (int i = 0; i < 33; ++i) { const float zv = Z[i * 64 + lane];
#pragma unroll
            for (int q = 0; q < 8; ++q) acc[q] += zv * w1[i * 64 + wv * 8 + q]; }
#pragma unroll
        for (int q = 0; q < 8; ++q) H1[(wv * 8 + q) * 64 + lane] = sinf(freq[wv * 8 + q] * acc[q]);
    }
    __syncthreads();
    {   float acc[8];
#pragma unroll
        for (int q = 0; q < 8; ++q) acc[q] = b2[wv * 8 + q];
#pragma unroll 2
        for (int i = 0; i < 64; ++i) { const float hv = H1[i * 64 + lane];
#pragma unroll
            for (int q = 0; q < 8; ++q) acc[q] += hv * w2[i * 64 + wv * 8 + q]; }
#pragma unroll
        for (int q = 0; q < 8; ++q) H2[(wv * 8 + q) * 64 + lane] = sinf(freq[wv * 8 + q] * acc[q]);
    }
    __syncthreads();
    const int t = t0 + lane; const float dist = fabsf((float)t - 4096.0f) * (1.0f / 4096.0f);
#pragma unroll 1
    for (int it = 0; it < 8; ++it) {
        const int oc0 = oq * 512 + wv * 64 + it * 8; float acc[8];
#pragma unroll
        for (int q = 0; q < 8; ++q) acc[q] = 0.f;
#pragma unroll 2
        for (int j = 0; j < 64; ++j) { const float hv = H2[j * 64 + lane];
#pragma unroll
            for (int q = 0; q < 8; ++q) acc[q] += hv * w3[j * 2048 + oc0 + q]; }
#pragma unroll
        for (int q = 0; q < 8; ++q) { const int oc = oc0 + q, ch = oc & 1023;
            const float decay = fabsf(-3.0701134573253944f + (-15.350567286626973f + 3.0701134573253944f) * ((float)ch * (1.0f / 1023.0f)));
            hfilt[(size_t)oc * 8192 + t] = acc[q] * (__expf(-dist * decay) + 0.05f); }
    }
    __syncthreads();
}
__device__ __forceinline__ void norm_row_bf16(const float* xrow, const float* g, const float* shift, const float* scale, bf16* orow, int lane) {
    const v4f* xr = (const v4f*)xrow + lane; v4f v[8]; float s = 0.f;
#pragma unroll
    for (int j = 0; j < 8; ++j) { v[j] = xr[64 * j]; s += (v[j][0] * v[j][0] + v[j][1] * v[j][1]) + (v[j][2] * v[j][2] + v[j][3] * v[j][3]); }
    const float rstd = 1.0f / sqrtf(wave_sum(s) * (1.0f / 2048.0f) + 1e-6f);
    v2u* o8 = (v2u*)orow + lane;
#pragma unroll
    for (int j = 0; j < 8; ++j) { const v4f gg = ((const v4f*)g)[lane + 64 * j], sh = ((const v4f*)shift)[lane + 64 * j], scl = ((const v4f*)scale)[lane + 64 * j];
        const v4f y = v[j] * rstd * gg * (scl + 1.0f) + sh; v2u w; w.x = pk2(y[0], y[1]); w.y = pk2(y[2], y[3]); o8[64 * j] = w; }
}
__device__ __forceinline__ void final_norm_row(float* xrow, const float* g, int lane) {
    v4f* xr = (v4f*)xrow + lane; v4f v[8]; float s = 0.f;
#pragma unroll
    for (int j = 0; j < 8; ++j) { v[j] = xr[64 * j]; s += (v[j][0] * v[j][0] + v[j][1] * v[j][1]) + (v[j][2] * v[j][2] + v[j][3] * v[j][3]); }
    const float rstd = 1.0f / sqrtf(wave_sum(s) * (1.0f / 2048.0f) + 1e-6f);
#pragma unroll
    for (int j = 0; j < 8; ++j) xr[64 * j] = v[j] * rstd * ((const v4f*)g)[lane + 64 * j];
}
__device__ __forceinline__ void transpose_item(const bf16* hyo, bf16* hytok, int item, LAS unsigned short* scr  , int lane) {
    const int cb = item >> 7, tb = item & 127, c0 = cb * 64, t0 = tb * 64;
#pragma unroll 8
    for (int i = 0; i < 32; ++i) { const int ch = 2 * i + (lane >> 5); const unsigned val = *(const unsigned*)(hyo + (size_t)(c0 + ch) * 8192 + t0 + 2 * (lane & 31));
        *(LAS unsigned*)(scr + ch * 66 + 2 * (lane & 31)) = val; }
    LDS_WAIT(); asm volatile("" ::: "memory");
    const int q = lane & 7;
#pragma unroll
    for (int it = 0; it < 8; ++it) { const int t = 8 * it + (lane >> 3); const LAS unsigned short* s = scr + (8 * q) * 66 + t;
        v4u o; o.x = (unsigned)s[0] | ((unsigned)s[66] << 16); o.y = (unsigned)s[2 * 66] | ((unsigned)s[3 * 66] << 16); o.z = (unsigned)s[4 * 66] | ((unsigned)s[5 * 66] << 16); o.w = (unsigned)s[6 * 66] | ((unsigned)s[7 * 66] << 16);
        *(v4u*)(hytok + (size_t)(t0 + t) * 1024 + c0 + 8 * q) = o; }
    LDS_WAIT(); asm volatile("" ::: "memory");
}


namespace cg = cooperative_groups;
struct Args { const float* in[31]; float* dst; unsigned char* ws; };
enum { I_X = 0, I_C, I_CTX, I_CCTX, I_WMOD, I_BMOD, I_GFFN1, I_W13A, I_W2A, I_GMIX, I_WIN, I_GQ, I_WUQ, I_GKV, I_WUKV, I_WAO, I_HCW, I_HCB, I_HW1, I_HB1, I_HW2, I_HB2, I_HW3, I_HFREQ, I_HSKIP, I_WHO, I_WOUT, I_GFFN2, I_W13B, I_W2B, I_GFINAL };

template <int PH_LO, int PH_HI>
__global__ void __launch_bounds__(512, 2) mk_fwd(Args args) {
    extern __shared__ __attribute__((aligned(16))) unsigned char lds_raw[];
    LAS unsigned char* lds = (LAS unsigned char*)lds_raw;
    const int wave = __builtin_amdgcn_readfirstlane((int)threadIdx.x >> 6);
#define PHASE_TID() const int lane = lane_id_fresh(), tid = wave * 64 + lane; (void)tid; (void)lane
    const int G = gridDim.x, bx = blockIdx.x;
    const int vcu = (G % 8 == 0) ? (bx % 8) * (G / 8) + bx / 8 : bx;
    const int gw = vcu * 8 + wave, NGW = G * 8;
    typedef const __attribute__((address_space(4))) Args* kargp_t;
    const kargp_t kp0 = (kargp_t)__builtin_amdgcn_kernarg_segment_ptr();
#define KP() ({ kargp_t p_ = kp0; asm volatile("" : "+s"(p_)); p_; })
#define WSB(off) (KP()->ws + (off))
#define INP(i) (KP()->in[i])
#define mods ((float*)WSB(WS_MODS))
#define rope ((float*)WSB(WS_ROPE))
#define qss ((float*)WSB(WS_QSS))
#define kvss ((float*)WSB(WS_KVSS))
#define W13A ((bf16*)WSB(WS_W13A))
#define W2A ((bf16*)WSB(WS_W2A))
#define WIN ((bf16*)WSB(WS_WIN))
#define WUQ ((bf16*)WSB(WS_WUQ))
#define WUKV ((bf16*)WSB(WS_WUKV))
#define WAO ((bf16*)WSB(WS_WAO))
#define WHO ((bf16*)WSB(WS_WHO))
#define WOUT ((bf16*)WSB(WS_WOUT))
#define W13B ((bf16*)WSB(WS_W13B))
#define W2B ((bf16*)WSB(WS_W2B))
#define HN ((bf16*)WSB(WS_HN))
#define ACT ((bf16*)WSB(WS_ACT))
#define X1 ((float*)WSB(WS_X1))
#define HYT ((bf16*)WSB(WS_HYT))
#define KV ((bf16*)WSB(WS_KV))
#define Q ((bf16*)WSB(WS_Q))
#define T ((float*)WSB(WS_T))
#define HYO ((bf16*)WSB(WS_HYO))
#define AX ((bf16*)WSB(WS_AX))
#define GATES ((bf16*)WSB(WS_GATES))
#define PQ ((bf16*)WSB(WS_PQ))
#define PKV ((bf16*)WSB(WS_PKV))
#define KR ((bf16*)WSB(WS_KR))
#define HYTOK ((bf16*)WSB(WS_HYTOK))
#define Y ((bf16*)WSB(WS_Y))
#define out (KP()->dst)
#define hfilt (KP()->dst)
    constexpr int lo = PH_LO, hi = PH_HI;
#ifndef PHASE_MASK
#define PHASE_MASK 0x3fff
#endif
#define IN(k) ((((PHASE_MASK) >> (k)) & 1) && lo <= (k) && (k) < hi)
#define SEAM(k) do { if (IN(k) && IN((k) + 1)) { cg::this_grid().sync(); } } while (0)

    if (IN(0)) {
        PHASE_TID();
        LAS float* sc = (LAS float*)lds; LAS float* red = (LAS float*)(lds + 16384);
        for (int i = tid; i < 4096; i += 512) { const float v = i < 2048 ? INP(I_C)[i] : INP(I_CCTX)[i - 2048]; sc[i] = v * fast_sigmoid(v); }
        __syncthreads();
        for (int u = bx; u < 288; u += G) mod_unit(u, INP(I_WMOD), INP(I_BMOD), mods, sc, red, tid);
        __syncthreads();
        if (bx == 0) for (int idx = tid; idx < 2048; idx += 512) { const int pos = idx >> 4, p = idx & 15; const float inv = powf(10000.0f, -(float)p * (1.0f / 16.0f)); const float ang = (float)pos * inv;
            rope[2 * idx] = cosf(ang); rope[2 * idx + 1] = sinf(ang); }
        {   LAS float* scr = (LAS float*)(lds + wave * 16384);
            constexpr int I13 = 32 * 352, I2 = 88 * 64, IIN = 32 * 264, IUQ = 8 * 96, IUKV = 8 * 128, IAO = 32 * 64, IHO = 16 * 64, IOUT = 32 * 64;
            constexpr int NITEMS = 2 * I13 + 2 * I2 + IIN + IUQ + IUKV + IAO + IHO + IOUT;
            for (int it = gw; it < NITEMS; it += NGW) {
                int r = it;
                if (r < I13) { cvt_item(INP(I_W13A), 2048, 11264, W13A, 352, ColW13(), nullptr, scr, r, lane); continue; } r -= I13;
                if (r < I2) { cvt_item(INP(I_W2A), 5632, 2048, W2A, 64, ColId(), nullptr, scr, r, lane); continue; } r -= I2;
                if (r < IIN) { cvt_item(INP(I_WIN), 2048, 8256, WIN, 264, ColWin(), nullptr, scr, r, lane); continue; } r -= IIN;
                if (r < IUQ) { cvt_item(INP(I_WUQ), 512, 3072, WUQ, 96, ColWuq(), INP(I_GQ), scr, r, lane); continue; } r -= IUQ;
                if (r < IUKV) { cvt_item(INP(I_WUKV), 512, 4096, WUKV, 128, ColId(), INP(I_GKV), scr, r, lane); continue; } r -= IUKV;
                if (r < IAO) { cvt_item(INP(I_WAO), 2048, 2048, WAO, 64, ColId(), nullptr, scr, r, lane); continue; } r -= IAO;
                if (r < IHO) { cvt_item(INP(I_WHO), 1024, 2048, WHO, 64, ColId(), nullptr, scr, r, lane); continue; } r -= IHO;
                if (r < IOUT) { cvt_item(INP(I_WOUT), 2048, 2048, WOUT, 64, ColId(), nullptr, scr, r, lane); continue; } r -= IOUT;
                if (r < I13) { cvt_item(INP(I_W13B), 2048, 11264, W13B, 352, ColW13(), nullptr, scr, r, lane); continue; } r -= I13;
                cvt_item(INP(I_W2B), 5632, 2048, W2B, 64, ColId(), nullptr, scr, r, lane);
            }
        }
        __syncthreads();
        for (int u = bx; u < 512; u += G)
            filter_unit(u, INP(I_HW1), INP(I_HB1), INP(I_HW2), INP(I_HB2), INP(I_HW3), INP(I_HFREQ), hfilt, (LAS float*)lds, (LAS float*)(lds + 16384), (LAS float*)(lds + 32768), tid);
    }
    SEAM(0);
    if (IN(1)) {
        PHASE_TID();
        for (int row = gw; row < MTOT; row += NGW) {
            const bool isc = row >= SEQ; const float* src = isc ? INP(I_CTX) + (size_t)(row - SEQ) * DM : INP(I_X) + (size_t)row * DM; const float* mv = mods + (isc ? 18432 : 0);
            norm_row_bf16(src, INP(I_GFFN1), mv + 0 * DM, mv + 1 * DM, HN + (size_t)row * DM, lane);
        }
    }
    SEAM(1);
    if (IN(2)) {
        PHASE_TID();
        pg8::Gemm g{HN, W13A, MTOT, 11264, 2048}; pg8::StaticOrder S; S.init(MTOT, 11264, G, bx);
        pg8::EpiSwiGLU E{ACT, DFF};
        pg8::gemm_phase<pg8::EpiSwiGLU, pg8::StaticOrder, true, true>(lds, g, S, E, tid);
    }
    SEAM(2);
    if (IN(3)) {
        PHASE_TID();
        pg8::Gemm g{ACT, W2A, MTOT, 2048, DFF}; pg8::StaticOrder S; S.init(MTOT, 2048, G, bx);
        pg8::EpiResid E{INP(I_X), INP(I_CTX), mods + 2 * DM, mods + 18432 + 2 * DM, X1, 0.5f};
        pg8::gemm_phase<pg8::EpiResid, pg8::StaticOrder, true, true>(lds, g, S, E, tid);
    }
    SEAM(3);
    if (IN(4)) {
        PHASE_TID();
        for (int row = gw; row < MTOT; row += NGW) {
            const float* mv = mods + (row >= SEQ ? 18432 : 0);
            norm_row_bf16(X1 + (size_t)row * DM, INP(I_GMIX), mv + 3 * DM, mv + 4 * DM, HN + (size_t)row * DM, lane);
        }
    }
    SEAM(4);
    if (IN(5)) {
        PHASE_TID();
        pg8::Gemm g{HN, WIN, MTOT, NINP, 2048}; pg8::InProjOrder S; S.init(G, bx);
        pg8::EpiInProj E{PQ, PKV, KR, HYT, GATES, qss, kvss, rope};
        pg8::gemm_phase<pg8::EpiInProj, pg8::InProjOrder, true, true>(lds, g, S, E, tid);
    }
    SEAM(5);
    if (IN(6)) {
        PHASE_TID();
        {   pg8::Gemm g{PQ, WUQ, SEQ, 3072, 512}; pg8::StaticOrder S; S.init(SEQ, 3072, G, bx);
            pg8::EpiQUp E{Q, qss, rope};
            pg8::gemm_phase<pg8::EpiQUp, pg8::StaticOrder, true, true>(lds, g, S, E, tid); }
        {   pg8::Gemm g{PKV, WUKV, MTOT, 4096, 512}; pg8::StaticOrder S; S.init(MTOT, 4096, G, bx);
            pg8::EpiKVUp E{KV, kvss};
            pg8::gemm_phase<pg8::EpiKVUp, pg8::StaticOrder, true, true>(lds, g, S, E, tid); }
        __syncthreads();
        for (int c = bx; c < HYW; c += G) hyena_unit(c, HYT, INP(I_HCW), INP(I_HCB), hfilt, INP(I_HSKIP), HYO, lds, tid);
    }
    SEAM(6);
    if (IN(7)) {
        PHASE_TID();
        for (int i = 0; ; ++i) {
            const int u = i * G + vcu; if (u >= HEADS * (SEQ / 256)) break;
            const int head = u >> 5, qb = u & 31;
            { const bf16* kvb = KV; att::attn_unit(Q + (size_t)(qb * 256) * 3072 + head * DQH, kvb, kvb + head * 256, KR, AX + (size_t)(qb * 256) * DM + head * DVH, MTOT, (LAS char*)lds, tid); }
        }
        __syncthreads();
        LAS unsigned short* scr = (LAS unsigned short*)(lds + wave * 16384);
        for (int it = gw; it < 2048; it += NGW) transpose_item(HYO, HYTOK, it, scr, lane);
    }
    SEAM(7);
    if (IN(8)) {
        PHASE_TID();
        pg8::StaticOrder S; S.init(SEQ, 2048, G, bx);
        {   pg8::Gemm g{AX, WAO, SEQ, 2048, 2048}; pg8::EpiMerge<0> E{GATES, T, Y};
            pg8::gemm_phase<pg8::EpiMerge<0>, pg8::StaticOrder, true, true>(lds, g, S, E, tid); }
        {   pg8::Gemm g{HYTOK, WHO, SEQ, 2048, 1024}; pg8::EpiMerge<1> E{GATES, T, Y};
            pg8::gemm_phase<pg8::EpiMerge<1>, pg8::StaticOrder, true, true>(lds, g, S, E, tid); }
    }
    SEAM(8);
    if (IN(9)) {
        PHASE_TID();
        pg8::Gemm g{Y, WOUT, SEQ, 2048, 2048}; pg8::StaticOrder S; S.init(SEQ, 2048, G, bx);
        pg8::EpiResid E{X1, X1, mods + 5 * DM, mods + 5 * DM, out, 1.0f};
        pg8::gemm_phase<pg8::EpiResid, pg8::StaticOrder, true, true>(lds, g, S, E, tid);
    }
    SEAM(9);
    if (IN(10)) {
        PHASE_TID();
        for (int row = gw; row < SEQ; row += NGW) norm_row_bf16(out + (size_t)row * DM, INP(I_GFFN2), mods + 6 * DM, mods + 7 * DM, HN + (size_t)row * DM, lane);
    }
    SEAM(10);
    if (IN(11)) {
        PHASE_TID();
        pg8::Gemm g{HN, W13B, SEQ, 11264, 2048}; pg8::StaticOrder S; S.init(SEQ, 11264, G, bx);
        pg8::EpiSwiGLU E{ACT, DFF};
        pg8::gemm_phase<pg8::EpiSwiGLU, pg8::StaticOrder, true, true>(lds, g, S, E, tid);
    }
    SEAM(11);
    if (IN(12)) {
        PHASE_TID();
        pg8::Gemm g{ACT, W2B, SEQ, 2048, DFF}; pg8::StaticOrder S; S.init(SEQ, 2048, G, bx);
        pg8::EpiResid E{out, out, mods + 8 * DM, mods + 8 * DM, out, 0.5f};
        pg8::gemm_phase<pg8::EpiResid, pg8::StaticOrder, true, true>(lds, g, S, E, tid);
    }
    SEAM(12);
    if (IN(13)) {
        PHASE_TID();
        for (int row = gw; row < SEQ; row += NGW) final_norm_row(out + (size_t)row * DM, INP(I_GFINAL), lane);
    }
#undef IN
#undef SEAM
#undef PHASE_TID
#undef KP
#undef WSB
#undef INP
#undef mods
#undef rope
#undef qss
#undef kvss
#undef W13A
#undef W2A
#undef WIN
#undef WUQ
#undef WUKV
#undef WAO
#undef WHO
#undef WOUT
#undef W13B
#undef W2B
#undef HN
#undef ACT
#undef X1
#undef HYT
#undef KV
#undef Q
#undef T
#undef HYO
#undef AX
#undef GATES
#undef PQ
#undef PKV
#undef KR
#undef HYTOK
#undef Y
#undef out
#undef hfilt
}


#ifdef DBG_STOP
struct DumpArgs { const void* p[4]; size_t n[4]; int isbf[4]; float* out; size_t nout; };
__global__ void __launch_bounds__(256) dbg_dump(DumpArgs d) {
    for (size_t i = blockIdx.x * 256ull + threadIdx.x; i < d.nout; i += (size_t)gridDim.x * 256ull) {
        float s = 0.f;
        for (int b = 0; b < 4; ++b) { if (!d.p[b]) continue;
            for (size_t j = i; j < d.n[b]; j += d.nout) s += d.isbf[b] ? bf2f(((const unsigned short*)d.p[b])[j]) : ((const float*)d.p[b])[j]; }
        d.out[i] = s;
    }
}
#endif
typedef void (*kern_t)(Args);
template <int K> struct PhaseTab { static void fill(kern_t* t) { t[K] = mk_fwd<K, K + 1>; PhaseTab<K - 1>::fill(t); } };
template <> struct PhaseTab<-1> { static void fill(kern_t*) {} };
extern "C" void kernel_launch(void* const* d_in, const int* in_sizes, int n_in, void* d_out, int out_size, void* d_ws, size_t ws_size, hipStream_t stream) {
    static int grid = 0;
    static kern_t tab[N_PHASES];
    if (grid == 0) {
        if (n_in != 31 || in_sizes[0] != SEQ * DM || out_size != SEQ * DM || ws_size < WS_END) {
            fprintf(stderr, "kernel_launch: unexpected problem: n_in %d in0 %d out %d ws %zu (need %zu); nothing launched\n", n_in, n_in > 0 ? in_sizes[0] : -1, out_size, ws_size, (size_t)WS_END); grid = -1; return; }
        int dev = 0, cus = 0;
        if (hipGetDevice(&dev) != hipSuccess || hipDeviceGetAttribute(&cus, hipDeviceAttributeMultiprocessorCount, dev) != hipSuccess) { grid = -1; return; }
#if MK_N_LAUNCHES == 1
        if (hipFuncSetAttribute((const void*)mk_fwd<0, N_PHASES>, hipFuncAttributeMaxDynamicSharedMemorySize, LDS_BYTES) != hipSuccess) { fprintf(stderr, "kernel_launch: hipFuncSetAttribute failed\n"); grid = -1; return; }
        int per_cu = 0;
        if (hipOccupancyMaxActiveBlocksPerMultiprocessor(&per_cu, (const void*)mk_fwd<0, N_PHASES>, 512, LDS_BYTES) != hipSuccess || per_cu < 1) { fprintf(stderr, "kernel_launch: occupancy query says %d blocks per CU\n", per_cu); }
#else
        PhaseTab<N_PHASES - 1>::fill(tab);
        for (int i = 0; i < N_PHASES; ++i)
            if (hipFuncSetAttribute((const void*)tab[i], hipFuncAttributeMaxDynamicSharedMemorySize, LDS_BYTES) != hipSuccess) { fprintf(stderr, "kernel_launch: hipFuncSetAttribute failed (phase %d)\n", i); grid = -1; return; }
#endif
        (void)hipGetLastError();
        grid = cus;
    }
    if (grid < 0) return;
    (void)hipMemsetAsync((char*)d_ws + WS_CTL, 0, 65536, stream);
    Args a{};
    for (int i = 0; i < 31; ++i) a.in[i] = (const float*)d_in[i];
    a.dst = (float*)d_out; a.ws = (unsigned char*)d_ws;
#if MK_N_LAUNCHES == 1
    void* kargs[] = {&a};
    hipError_t e = hipLaunchCooperativeKernel((const void*)mk_fwd<0, N_PHASES>, dim3(grid), dim3(512), kargs, LDS_BYTES, stream);
    if (e != hipSuccess) fprintf(stderr, "kernel_launch: cooperative launch failed: %s (grid %d)\n", hipGetErrorString(e), grid);
#else
#ifdef DBG_STOP
    for (int li = 0; li <= DBG_STOP; ++li) hipLaunchKernelGGL(tab[li], dim3(grid), dim3(512), LDS_BYTES, stream, a);
    {   DumpArgs d{}; unsigned char* w = (unsigned char*)d_ws; d.out = (float*)d_out; d.nout = (size_t)SEQ * DM;
#if DBG_STOP == 6
        d.p[0] = w + WS_Q; d.n[0] = (size_t)8192 * 3072; d.isbf[0] = 1; d.p[1] = w + WS_KV; d.n[1] = (size_t)MTOT * 4096; d.isbf[1] = 1; d.p[2] = w + WS_HYO; d.n[2] = (size_t)1024 * 8192; d.isbf[2] = 1;
#elif DBG_STOP == 5
        d.p[0] = w + WS_GATES; d.n[0] = (size_t)8192 * 4096; d.isbf[0] = 1; d.p[1] = w + WS_PQ; d.n[1] = (size_t)8192 * 512 + (size_t)MTOT * 512 + (size_t)MTOT * 64; d.isbf[1] = 1; d.p[2] = w + WS_HYT; d.n[2] = (size_t)3072 * 8192; d.isbf[2] = 1; d.p[3] = w + WS_QSS; d.n[3] = (size_t)MTOT * 8; d.isbf[3] = 0;
#elif DBG_STOP == 3
        d.p[0] = w + WS_X1; d.n[0] = (size_t)MTOT * 2048; d.isbf[0] = 0;
#elif DBG_STOP == 2
        d.p[0] = w + WS_ACT; d.n[0] = (size_t)MTOT * DFF; d.isbf[0] = 1;
#elif DBG_STOP == 1
        d.p[0] = w + WS_HN; d.n[0] = (size_t)MTOT * 2048; d.isbf[0] = 1;
#elif DBG_STOP == 0
        d.p[0] = w + WS_W13A; d.n[0] = (WS_HN - WS_W13A) / 2; d.isbf[0] = 1; d.p[1] = w + WS_MODS; d.n[1] = 2 * 18432; d.isbf[1] = 0; d.p[2] = w + WS_ROPE; d.n[2] = 4096; d.isbf[2] = 0;
#elif DBG_STOP == 7
        d.p[0] = w + WS_AX; d.n[0] = (size_t)8192 * 2048; d.isbf[0] = 1; d.p[1] = w + WS_HYTOK; d.n[1] = (size_t)8192 * 1024; d.isbf[1] = 1;
#elif DBG_STOP == 8
        d.p[0] = w + WS_Y; d.n[0] = (size_t)8192 * 2048; d.isbf[0] = 1;
#endif
        hipLaunchKernelGGL(dbg_dump, dim3(2048), dim3(256), 0, stream, d); }
#else
    for (int li = 0; li < N_PHASES; ++li) hipLaunchKernelGGL(tab[li], dim3(grid), dim3(512), LDS_BYTES, stream, a);
#endif
    const hipError_t le = hipPeekAtLastError();
    if (le != hipSuccess) fprintf(stderr, "kernel_launch: launch failed: %s\n", hipGetErrorName(le));
#endif
}
```

```cpp
#include <hip/hip_runtime.h>
#include <hip/hip_cooperative_groups.h>
#include <cstdio>
#include <cstdint>
#include <cmath>

#ifndef MK_N_LAUNCHES
#define MK_N_LAUNCHES 1
#endif
constexpr int N_PHASES = 14;

constexpr int DM = 2048, SEQ = 8192, CTXL = 256, MTOT = SEQ + CTXL, DFF = 5632;
constexpr int HEADS = 16, QLORA = 512, KVLORA = 512, DNOPE = 128, DROPE = 64, DVH = 128, DQH = 192;
constexpr int HYW = 1024, NINP = 8448;
constexpr float NORM_EPS = 1e-6f;

constexpr size_t WS_CTL = 0;
constexpr size_t WS_MODS = 64 * 1024;
constexpr size_t WS_ROPE = 256 * 1024;
constexpr size_t WS_QSS = 320 * 1024;
constexpr size_t WS_KVSS = 640 * 1024;
constexpr size_t WS_W13A = 1u << 20;
constexpr size_t WS_W2A = WS_W13A + (size_t)11264 * 2048 * 2;
constexpr size_t WS_WIN = WS_W2A + (size_t)2048 * 5632 * 2;
constexpr size_t WS_WUQ = WS_WIN + (size_t)NINP * 2048 * 2;
constexpr size_t WS_WUKV = WS_WUQ + (size_t)3072 * 512 * 2;
constexpr size_t WS_WAO = WS_WUKV + (size_t)4096 * 512 * 2;
constexpr size_t WS_WHO = WS_WAO + (size_t)2048 * 2048 * 2;
constexpr size_t WS_WOUT = WS_WHO + (size_t)2048 * 1024 * 2;
constexpr size_t WS_W13B = WS_WOUT + (size_t)2048 * 2048 * 2;
constexpr size_t WS_W2B = WS_W13B + (size_t)11264 * 2048 * 2;
constexpr size_t WS_HN = WS_W2B + (size_t)2048 * 5632 * 2;
constexpr size_t WS_ACT = WS_HN + (size_t)MTOT * 2048 * 2;
constexpr size_t WS_X1 = WS_ACT + (size_t)MTOT * DFF * 2;
constexpr size_t WS_HYT = WS_X1 + (size_t)MTOT * 2048 * 4;
constexpr size_t WS_KV = WS_HYT + (size_t)3072 * 8192 * 2;
constexpr size_t WS_END = WS_KV + (size_t)MTOT * 4096 * 2;
constexpr size_t WS_Q = WS_W13A;
constexpr size_t WS_T = WS_W13A;
constexpr size_t WS_HYO = WS_WIN;
constexpr size_t WS_AX = WS_HN;
constexpr size_t WS_GATES = WS_ACT;
constexpr size_t WS_PQ = WS_GATES + (size_t)8192 * 4096 * 2;
constexpr size_t WS_PKV = WS_PQ + (size_t)8192 * 512 * 2;
constexpr size_t WS_KR = WS_PKV + (size_t)MTOT * 512 * 2;
constexpr size_t WS_HYTOK = WS_HYT;
constexpr size_t WS_Y = WS_KV;
static_assert(WS_KR + (size_t)MTOT * 64 * 2 <= WS_X1, "ACT overlay");
static_assert((size_t)8192 * 3072 * 2 <= WS_WIN - WS_W13A && (size_t)8192 * 2048 * 4 <= WS_WIN - WS_W13A, "Q/T overlay");

constexpr int LDS_BYTES = 163840;
constexpr int LDS_CTL_OFF = LDS_BYTES - 512;

typedef unsigned short bf16;
#define GAS __attribute__((address_space(1)))
#define LAS __attribute__((address_space(3)))
typedef unsigned v4u __attribute__((ext_vector_type(4)));
typedef unsigned v2u __attribute__((ext_vector_type(2)));
typedef float v4f __attribute__((ext_vector_type(4)));
#define LDS_WAIT() asm volatile("s_waitcnt lgkmcnt(0)" ::: "memory")
#define VM_WAIT() asm volatile("s_waitcnt vmcnt(0)" ::: "memory")
__device__ __forceinline__ unsigned f2bf(float f) { unsigned u = __builtin_bit_cast(unsigned, f); return (u + 0x7fffu + ((u >> 16) & 1u)) >> 16; }
__device__ __forceinline__ unsigned pk2(float lo, float hi) { return f2bf(lo) | (f2bf(hi) << 16); }
__device__ __forceinline__ float bf2f(unsigned short b) { return __builtin_bit_cast(float, (unsigned)b << 16); }
__device__ __forceinline__ float fast_sigmoid(float v) { return __builtin_amdgcn_rcpf(1.f + __builtin_amdgcn_exp2f(-1.4426950408889634f * v)); }
__device__ __forceinline__ float wave_sum(float v) {
#pragma unroll
    for (int o = 1; o < 64; o <<= 1) v += __shfl_xor(v, o);
    return v;
}

__device__ __forceinline__ int lane_id_fresh() { int l; asm volatile("v_mbcnt_lo_u32_b32 %0, -1, 0\n\tv_mbcnt_hi_u32_b32 %0, -1, %0" : "=v"(l)); return l; }
namespace pg8 {
#define PG8_LAS __attribute__((address_space(3)))
typedef unsigned short bf16_t;
typedef short bf16x8 __attribute__((ext_vector_type(8)));
typedef float f32x4 __attribute__((ext_vector_type(4)));
typedef unsigned u32x4 __attribute__((ext_vector_type(4)));
constexpr int BM = 256, BK = 64, HALF = 128, HTB = HALF * BK * 2  , STAGE_BYTES = 8 * HTB, NXCD = 8, WGM = 8;

__host__ __device__ __forceinline__ int lds_byte(int r, int c) { const int st = (r >> 4) * 2 + (c >> 5), rr = r & 15, cc = c & 31, ob = rr * 64 + cc * 2; return st * 1024 + (ob ^ (((ob >> 9) & 1) << 5)); }
__host__ __device__ __forceinline__ void stage_rc(int b, int& R, int& C) { const int st = b / 1024, sb = b % 1024, swz = sb ^ (((sb >> 9) & 1) << 5); R = (st >> 1) * 16 + swz / 64; C = (st & 1) * 32 + (swz % 64) / 2; }
__host__ __device__ __forceinline__ int perm32(int rho) { const int n = rho >> 4, i = rho & 15; return 8 * (i >> 2) + 4 * n + (i & 3); }

struct Unit { int pm, pn; };
struct Gemm { const bf16_t* A; const bf16_t* Bt; int M, N, K; };

struct StaticOrder {
    int nM, nN, nwg, G, c;
    __host__ __device__ void init(int M, int N, int G_, int c_) { nM = M / BM; nN = N / BM; nwg = nM * nN; G = G_; c = c_; }
    __host__ __device__ bool next(int i, Unit& u) const {
        const long L = (long)i * G + c; if (L >= nwg) return false;
        int wgid = (int)L; { const int q = nwg / NXCD, r = nwg % NXCD, xcd = wgid % NXCD, off = wgid / NXCD; wgid = (xcd < r ? xcd * (q + 1) : r * (q + 1) + (xcd - r) * q) + off; }
        const int nig = WGM * nN, gid = wgid / nig, fm = gid * WGM, gsz = (nM - fm) < WGM ? (nM - fm) : WGM;
        u.pm = fm + ((wgid % nig) % gsz); u.pn = (wgid % nig) / gsz; return true;
    }
    __device__ __forceinline__ void a_ready(const Unit&) const {}
    __device__ __forceinline__ void done(const Unit&) const {}
};


typedef float f32x2_t __attribute__((ext_vector_type(2))); typedef __bf16 bf16x2_t __attribute__((ext_vector_type(2)));
__device__ __forceinline__ unsigned cvt_pk_bf16(float lo, float hi) { f32x2_t v = {lo, hi}; bf16x2_t b = __builtin_convertvector(v, bf16x2_t); return __builtin_bit_cast(unsigned, b); }
__device__ __forceinline__ u32x4 pack8(const f32x4 v0, const f32x4 v1) { u32x4 w; w.x = cvt_pk_bf16(v0[0], v0[1]); w.y = cvt_pk_bf16(v0[2], v0[3]); w.z = cvt_pk_bf16(v1[0], v1[1]); w.w = cvt_pk_bf16(v1[2], v1[3]); return w; }
__device__ __forceinline__ float sigm(float v) { return __builtin_amdgcn_rcpf(1.f + __builtin_amdgcn_exp2f(-1.4426950408889634f * v)); }

struct EpiSwiGLU {
    static constexpr bool PERM = true, AFTER_DRAIN = false;
    bf16_t* O; int ldc;
    __device__ __forceinline__ void operator()(const f32x4 (&acc)[2][2][4][2], const Unit& u, int wr, int wc, int fr, int fq) const {
        const int row0 = u.pm * BM + wr * 64 + fr, col0 = u.pn * HALF + wc * 32 + 8 * fq;
#pragma unroll
        for (int ai = 0; ai < 2; ++ai)
#pragma unroll
            for (int m = 0; m < 4; ++m) {
                bf16_t* rowp = O + (size_t)(row0 + ai * HALF + m * 16) * ldc + col0;
                f32x4 v[2];
#pragma unroll
                for (int n = 0; n < 2; ++n)
#pragma unroll
                    for (int e = 0; e < 4; ++e) { const float a = acc[ai][0][m][n][e], b = acc[ai][1][m][n][e]; v[n][e] = a * sigm(a) * b; }
                *(u32x4*)rowp = pack8(v[0], v[1]);
            }
    }
};
struct EpiResid {
    static constexpr bool PERM = false, AFTER_DRAIN = false;
    const float* base_x; const float* base_c; const float* gate_x; const float* gate_c; float* out; float coef;
    __device__ __forceinline__ void operator()(const f32x4 (&acc)[2][2][4][2], const Unit& u, int wr, int wc, int fr, int fq) const {
        const bool isc = u.pm >= 32;
        const int row0 = u.pm * BM + wr * 64 + fr, col0 = u.pn * BM + wc * 32 + 4 * fq;
        const float* gate = isc ? gate_c : gate_x;
        f32x4 gv[2][2];
#pragma unroll
        for (int bj = 0; bj < 2; ++bj)
#pragma unroll
            for (int n = 0; n < 2; ++n) gv[bj][n] = *(const f32x4*)(gate + col0 + bj * HALF + n * 16) * coef;
#pragma unroll
        for (int ai = 0; ai < 2; ++ai)
#pragma unroll
            for (int m = 0; m < 4; ++m) {
                const int row = row0 + ai * HALF + m * 16;
                const float* bp = (isc ? base_c + (size_t)(row - 8192) * 2048 : base_x + (size_t)row * 2048) + col0;
                float* op = out + (size_t)row * 2048 + col0;
#pragma unroll
                for (int bj = 0; bj < 2; ++bj)
#pragma unroll
                    for (int n = 0; n < 2; ++n) { const f32x4 b = *(const f32x4*)(bp + bj * HALF + n * 16); *(f32x4*)(op + bj * HALF + n * 16) = b + gv[bj][n] * acc[ai][bj][m][n]; }
            }
    }
};
struct EpiInProj {
    static constexpr bool PERM = true, AFTER_DRAIN = false;
    bf16_t* pq; bf16_t* pkv; bf16_t* kr; bf16_t* hyT; bf16_t* gates; float* qss; float* kvss; const float* rope;
    __device__ __forceinline__ void operator()(const f32x4 (&acc)[2][2][4][2], const Unit& u, int wr, int wc, int fr, int fq) const {
        const int row0 = u.pm * BM + wr * 64 + fr, pn = u.pn;
        if (pn < 4) {
            bf16_t* O = pn < 2 ? pq : pkv; float* ss = pn < 2 ? qss : kvss; const int t = pn & 1;
            const int col0 = t * BM + wc * 32 + 8 * fq;
#pragma unroll
            for (int ai = 0; ai < 2; ++ai)
#pragma unroll
                for (int m = 0; m < 4; ++m) {
                    const int row = row0 + ai * HALF + m * 16; float s = 0.f;
#pragma unroll
                    for (int bj = 0; bj < 2; ++bj) {
                        const f32x4 v0 = acc[ai][bj][m][0], v1 = acc[ai][bj][m][1];
                        s += (v0[0] * v0[0] + v0[1] * v0[1]) + (v0[2] * v0[2] + v0[3] * v0[3]) + (v1[0] * v1[0] + v1[1] * v1[1]) + (v1[2] * v1[2] + v1[3] * v1[3]);
                        *(u32x4*)(O + (size_t)row * 512 + col0 + bj * HALF) = pack8(v0, v1);
                    }
                    s += __shfl_xor(s, 16); s += __shfl_xor(s, 32);
                    if (fq == 0) ss[(size_t)row * 8 + t * 4 + wc] = s;
                }
        } else if (pn < 16) {
            const int ch0 = (pn - 4) * BM + wc * 32 + 8 * fq;
#pragma unroll
            for (int ai = 0; ai < 2; ++ai)
#pragma unroll
                for (int m = 0; m < 4; ++m) {
                    const int row = row0 + ai * HALF + m * 16;
#pragma unroll
                    for (int bj = 0; bj < 2; ++bj)
#pragma unroll
                        for (int n = 0; n < 2; ++n)
#pragma unroll
                            for (int e = 0; e < 4; ++e) hyT[(size_t)(ch0 + bj * HALF + 4 * n + e) * 8192 + row] = (bf16_t)(cvt_pk_bf16(acc[ai][bj][m][n][e], 0.f) & 0xffffu);
                }
        } else if (pn < 32) {
            const int col0 = (pn - 16) * BM + wc * 32 + 8 * fq;
#pragma unroll
            for (int ai = 0; ai < 2; ++ai)
#pragma unroll
                for (int m = 0; m < 4; ++m) {
                    const int row = row0 + ai * HALF + m * 16;
#pragma unroll
                    for (int bj = 0; bj < 2; ++bj) {
                        f32x4 v0 = acc[ai][bj][m][0], v1 = acc[ai][bj][m][1];
#pragma unroll
                        for (int e = 0; e < 4; ++e) { v0[e] = sigm(v0[e]); v1[e] = sigm(v1[e]); }
                        *(u32x4*)(gates + (size_t)row * 4096 + col0 + bj * HALF) = pack8(v0, v1);
                    }
                }
        } else {
            if (wc < 2) {
#pragma unroll
                for (int ai = 0; ai < 2; ++ai)
#pragma unroll
                    for (int m = 0; m < 4; ++m) {
                        const int row = row0 + ai * HALF + m * 16;
                        f32x4 v[2] = {acc[ai][0][m][0], acc[ai][0][m][1]};
                        if (row < 8192) {
                            const int pos = wc == 0 ? (row >> 6) : (row & 63);
#pragma unroll
                            for (int n = 0; n < 2; ++n) {
                                const f32x4 cs = *(const f32x4*)(rope + (size_t)(pos * 16 + 4 * fq + 2 * n) * 2);
                                const float a0 = v[n][0], b0 = v[n][1], a1 = v[n][2], b1 = v[n][3];
                                v[n][0] = a0 * cs[0] - b0 * cs[1]; v[n][1] = a0 * cs[1] + b0 * cs[0];
                                v[n][2] = a1 * cs[2] - b1 * cs[3]; v[n][3] = a1 * cs[3] + b1 * cs[2];
                            }
                        }
                        *(u32x4*)(kr + (size_t)row * 64 + wc * 32 + 8 * fq) = pack8(v[0], v[1]);
                    }
            }
        }
    }
};
struct EpiQUp {
    static constexpr bool PERM = true, AFTER_DRAIN = false;
    bf16_t* Q; const float* qss; const float* rope;
    __device__ __forceinline__ void operator()(const f32x4 (&acc)[2][2][4][2], const Unit& u, int wr, int wc, int fr, int fq) const {
        const int row0 = u.pm * BM + wr * 64 + fr;
#pragma unroll
        for (int ai = 0; ai < 2; ++ai)
#pragma unroll
            for (int m = 0; m < 4; ++m) {
                const int row = row0 + ai * HALF + m * 16;
                const f32x4 s0 = *(const f32x4*)(qss + (size_t)row * 8), s1 = *(const f32x4*)(qss + (size_t)row * 8 + 4);
                const float r = 1.0f / sqrtf(((s0[0] + s0[1]) + (s0[2] + s0[3]) + (s1[0] + s1[1]) + (s1[2] + s1[3])) * (1.0f / 512.0f) + 1e-6f);
#pragma unroll
                for (int bj = 0; bj < 2; ++bj) {
                    const int c32 = u.pn * 8 + bj * 4 + wc, gt = c32 % 6;
                    f32x4 v[2] = {acc[ai][bj][m][0] * r, acc[ai][bj][m][1] * r};
                    if (gt >= 4) {
                        const int pos = gt == 4 ? (row >> 6) : (row & 63);
#pragma unroll
                        for (int n = 0; n < 2; ++n) {
                            const f32x4 cs = *(const f32x4*)(rope + (size_t)(pos * 16 + 4 * fq + 2 * n) * 2);
                            const float a0 = v[n][0], b0 = v[n][1], a1 = v[n][2], b1 = v[n][3];
                            v[n][0] = a0 * cs[0] - b0 * cs[1]; v[n][1] = a0 * cs[1] + b0 * cs[0];
                            v[n][2] = a1 * cs[2] - b1 * cs[3]; v[n][3] = a1 * cs[3] + b1 * cs[2];
                        }
                    }
                    *(u32x4*)(Q + (size_t)row * 3072 + c32 * 32 + 8 * fq) = pack8(v[0], v[1]);
                }
            }
    }
};
struct EpiKVUp {
    static constexpr bool PERM = true, AFTER_DRAIN = false;
    bf16_t* KV; const float* kvss;
    __device__ __forceinline__ void operator()(const f32x4 (&acc)[2][2][4][2], const Unit& u, int wr, int wc, int fr, int fq) const {
        const int row0 = u.pm * BM + wr * 64 + fr, col0 = u.pn * BM + wc * 32 + 8 * fq;
#pragma unroll
        for (int ai = 0; ai < 2; ++ai)
#pragma unroll
            for (int m = 0; m < 4; ++m) {
                const int row = row0 + ai * HALF + m * 16;
                const f32x4 s0 = *(const f32x4*)(kvss + (size_t)row * 8), s1 = *(const f32x4*)(kvss + (size_t)row * 8 + 4);
                const float r = 1.0f / sqrtf(((s0[0] + s0[1]) + (s0[2] + s0[3]) + (s1[0] + s1[1]) + (s1[2] + s1[3])) * (1.0f / 512.0f) + 1e-6f);
#pragma unroll
                for (int bj = 0; bj < 2; ++bj) *(u32x4*)(KV + (size_t)row * 4096 + col0 + bj * HALF) = pack8(acc[ai][bj][m][0] * r, acc[ai][bj][m][1] * r);
            }
    }
};
template <int PASS> struct EpiMerge {
    static constexpr bool PERM = true, AFTER_DRAIN = false;
    const bf16_t* gates; float* T; bf16_t* Y;
    __device__ __forceinline__ void operator()(const f32x4 (&acc)[2][2][4][2], const Unit& u, int wr, int wc, int fr, int fq) const {
        const int row0 = u.pm * BM + wr * 64 + fr, col0 = u.pn * BM + wc * 32 + 8 * fq;
#pragma unroll
        for (int ai = 0; ai < 2; ++ai)
#pragma unroll
            for (int m = 0; m < 4; ++m) {
                const int row = row0 + ai * HALF + m * 16;
#pragma unroll
                for (int bj = 0; bj < 2; ++bj) {
                    const int col = col0 + bj * HALF;
                    const u32x4 g = *(const u32x4*)(gates + (size_t)row * 4096 + PASS * 2048 + col);
                    f32x4 g0, g1;
                    g0[0] = __builtin_bit_cast(float, g.x << 16); g0[1] = __builtin_bit_cast(float, g.x & 0xffff0000u); g0[2] = __builtin_bit_cast(float, g.y << 16); g0[3] = __builtin_bit_cast(float, g.y & 0xffff0000u);
                    g1[0] = __builtin_bit_cast(float, g.z << 16); g1[1] = __builtin_bit_cast(float, g.z & 0xffff0000u); g1[2] = __builtin_bit_cast(float, g.w << 16); g1[3] = __builtin_bit_cast(float, g.w & 0xffff0000u);
                    float* tp = T + (size_t)row * 2048 + col;
                    if (PASS == 0) { *(f32x4*)tp = g0 * acc[ai][bj][m][0]; *(f32x4*)(tp + 4) = g1 * acc[ai][bj][m][1]; }
                    else { const f32x4 t0 = *(const f32x4*)tp, t1 = *(const f32x4*)(tp + 4);
                        *(u32x4*)(Y + (size_t)row * 2048 + col) = pack8(t0 + g0 * acc[ai][bj][m][0], t1 + g1 * acc[ai][bj][m][1]); }
                }
            }
    }
};
struct InProjOrder {
    StaticOrder base; int G, c;
    __host__ __device__ void init(int G_, int c_) { base.init(8192, 8448, G_, c_); G = G_; c = c_; }
    __host__ __device__ bool next(int i, Unit& u) const {
        if (base.next(i, u)) return true;
        const long L = (long)i * G + c - base.nwg; if (L < 0 || L >= 3) return false;
        u.pm = 32; u.pn = L == 0 ? 2 : (L == 1 ? 3 : 32); return true;
    }
    __device__ __forceinline__ void a_ready(const Unit&) const {}
    __device__ __forceinline__ void done(const Unit&) const {}
};

template <class Epi, class Sched, bool ALIGN_EPI = false, bool SP2 = false>
__device__ __forceinline__ void gemm_phase(PG8_LAS unsigned char* lds, const Gemm g, const Sched& S, const Epi& E, const int tid) {
    const int wid = __builtin_amdgcn_readfirstlane(tid >> 6), lane = tid & 63, wr = wid >> 2, wc = wid & 3, fr = lane & 15, fq = lane >> 4;
    const int K = g.K, nt = K / BK;
    unsigned voffA[2], voffB[2];
#pragma unroll
    for (int i = 0; i < 2; ++i) { int R, C; stage_rc(tid * 16 + i * 8192, R, C); const int Rb = Epi::PERM ? ((R & ~31) + perm32(R & 31)) : R;
        voffA[i] = (unsigned)(R * K + C) * 2u; voffB[i] = (unsigned)(Rb * K + C) * 2u; }
    const size_t kstep = (size_t)(BK * 2);
    const size_t hstep = (size_t)HALF * K * 2;
    const size_t tstep = 2 * hstep;
    const unsigned ldsw = (unsigned)wid * 1024u;
    const int aoff = lds_byte(wr * 64 + fr, fq * 8), boff = lds_byte(wc * 32 + fr, fq * 8);
#define PG8_SA(b, h) (((b) * 2 + (h)) * HTB)
#define PG8_SB(b, h) ((4 + (b) * 2 + (h)) * HTB)
#define PG8_STAGE(bufoff, gbase, voff) do { _Pragma("unroll") for (int _i = 0; _i < 2; ++_i) \
        __builtin_amdgcn_global_load_lds((const unsigned*)((const char*)(gbase) + (voff)[_i]), (PG8_LAS unsigned*)(lds + (bufoff) + ldsw + _i * 8192), 16, 0, 0); } while (0)
#define PG8_LDA(dst, b, h) do { _Pragma("unroll") for (int m = 0; m < 4; ++m) _Pragma("unroll") for (int k = 0; k < 2; ++k) dst[m][k] = *(const PG8_LAS bf16x8*)(lds + PG8_SA(b, h) + aoff + m * 2048 + k * 1024); } while (0)
#define PG8_LDB(dst, b, h) do { _Pragma("unroll") for (int n = 0; n < 2; ++n) _Pragma("unroll") for (int k = 0; k < 2; ++k) dst[n][k] = *(const PG8_LAS bf16x8*)(lds + PG8_SB(b, h) + boff + n * 2048 + k * 1024); } while (0)
#define PG8_MMA(ai, bj, At, Bt) do { __builtin_amdgcn_s_setprio(1); _Pragma("unroll") for (int m = 0; m < 4; ++m) _Pragma("unroll") for (int n = 0; n < 2; ++n) _Pragma("unroll") for (int k = 0; k < 2; ++k) \
        acc[ai][bj][m][n] = __builtin_amdgcn_mfma_f32_16x16x32_bf16(Bt[n][k], At[m][k], acc[ai][bj][m][n], 0, 0, 0); __builtin_amdgcn_s_setprio(0); } while (0)
#define PG8_WAIT_V(n) asm volatile("s_waitcnt vmcnt(" #n ")" ::: "memory")
#define PG8_WAIT_L(n) asm volatile("s_waitcnt lgkmcnt(" #n ")" ::: "memory")
#define PG8_BAR __builtin_amdgcn_s_barrier()
#define PG8_SCHED __builtin_amdgcn_sched_barrier(0)
    Unit cur, nxt; int ui = 0;
    if (!S.next(0, cur)) return;
    f32x4 acc[2][2][4][2];
#pragma unroll
    for (int a = 0; a < 2; ++a)
#pragma unroll
        for (int b = 0; b < 2; ++b)
#pragma unroll
            for (int m = 0; m < 4; ++m)
#pragma unroll
                for (int n = 0; n < 2; ++n) acc[a][b][m][n] = (f32x4){0.f, 0.f, 0.f, 0.f};
    bf16x8 At[4][2], B0[2][2], B1[2][2];
    const char* cA = (const char*)g.A + (size_t)cur.pm * tstep; const char* cB = (const char*)g.Bt + (size_t)cur.pn * tstep;
    S.a_ready(cur);
    if constexpr (SP2) {
        PG8_STAGE(PG8_SB(0, 0), cB, voffB); PG8_STAGE(PG8_SB(0, 1), cB + hstep, voffB); PG8_STAGE(PG8_SA(0, 0), cA, voffA); PG8_STAGE(PG8_SA(0, 1), cA + hstep, voffA);
        if (wr == 1) PG8_BAR;
        PG8_WAIT_V(2); PG8_BAR;
        PG8_STAGE(PG8_SB(1, 0), cB + kstep, voffB); PG8_STAGE(PG8_SA(1, 0), cA + kstep, voffA); PG8_STAGE(PG8_SB(1, 1), cB + hstep + kstep, voffB);
        PG8_WAIT_V(6); PG8_BAR;
    } else {
        PG8_STAGE(PG8_SB(0, 0), cB, voffB); PG8_STAGE(PG8_SA(0, 0), cA, voffA); PG8_STAGE(PG8_SB(0, 1), cB + hstep, voffB); PG8_STAGE(PG8_SA(0, 1), cA + hstep, voffA);
        if (wr == 1) PG8_BAR;
        PG8_WAIT_V(4); PG8_BAR;
        PG8_STAGE(PG8_SB(1, 0), cB + kstep, voffB); PG8_STAGE(PG8_SA(1, 0), cA + kstep, voffA); PG8_STAGE(PG8_SB(1, 1), cB + hstep + kstep, voffB);
        PG8_WAIT_V(6); PG8_BAR;
    }
    for (;;) {
        const bool has_next = S.next(ui + 1, nxt);
        const char* nA = has_next ? (const char*)g.A + (size_t)nxt.pm * tstep : cA; const char* nB = has_next ? (const char*)g.Bt + (size_t)nxt.pn * tstep : cB;
        for (int t = 0; t < nt; t += 2) {
            const bool last = (t == nt - 2);
            const char* a1 = cA + (size_t)(t + 1) * kstep;
            const char* a2 = last ? nA : cA + (size_t)(t + 2) * kstep; const char* b2 = last ? nB : cB + (size_t)(t + 2) * kstep;
            const char* a3 = a2 + kstep; const char* b3 = b2 + kstep;
            if (last && has_next) S.a_ready(nxt);
            if constexpr (SP2) {
            PG8_LDB(B0, 0, 0); PG8_LDB(B1, 0, 1); PG8_SCHED; PG8_LDA(At, 0, 0); PG8_STAGE(PG8_SA(1, 1), a1 + hstep, voffA);
            PG8_WAIT_V(8); PG8_WAIT_L(0); PG8_BAR; PG8_MMA(0, 0, At, B0); PG8_MMA(0, 1, At, B1); PG8_BAR; PG8_SCHED;
            PG8_LDA(At, 0, 1); PG8_STAGE(PG8_SB(0, 0), b2, voffB); PG8_STAGE(PG8_SB(0, 1), b2 + hstep, voffB); PG8_STAGE(PG8_SA(0, 0), a2, voffA);
            PG8_WAIT_V(8); PG8_WAIT_L(0); PG8_BAR; PG8_MMA(1, 0, At, B0); PG8_MMA(1, 1, At, B1); PG8_BAR; PG8_SCHED;
            PG8_LDB(B0, 1, 0); PG8_LDB(B1, 1, 1); PG8_SCHED; PG8_LDA(At, 1, 0); PG8_STAGE(PG8_SA(0, 1), a2 + hstep, voffA);
            PG8_WAIT_V(8); PG8_WAIT_L(0); PG8_BAR; PG8_MMA(0, 0, At, B0); PG8_MMA(0, 1, At, B1); PG8_BAR; PG8_SCHED;
            PG8_LDA(At, 1, 1); PG8_STAGE(PG8_SB(1, 0), b3, voffB); PG8_STAGE(PG8_SB(1, 1), b3 + hstep, voffB); PG8_STAGE(PG8_SA(1, 0), a3, voffA);
            PG8_WAIT_V(8); PG8_WAIT_L(0); PG8_BAR; PG8_MMA(1, 0, At, B0); PG8_MMA(1, 1, At, B1); PG8_BAR; PG8_SCHED;
            } else {
            PG8_LDB(B0, 0, 0); PG8_SCHED; PG8_LDA(At, 0, 0); PG8_STAGE(PG8_SA(1, 1), a1 + hstep, voffA);
            PG8_WAIT_L(8); PG8_BAR; PG8_WAIT_L(0); PG8_MMA(0, 0, At, B0); PG8_BAR; PG8_SCHED;
            PG8_LDB(B1, 0, 1); PG8_STAGE(PG8_SB(0, 0), b2, voffB);
            PG8_BAR; PG8_WAIT_L(0); PG8_MMA(0, 1, At, B1); PG8_BAR;
            PG8_LDA(At, 0, 1); PG8_STAGE(PG8_SA(0, 0), a2, voffA);
            PG8_BAR; PG8_WAIT_L(0); PG8_MMA(1, 0, At, B0); PG8_BAR; PG8_SCHED;
            PG8_STAGE(PG8_SB(0, 1), b2 + hstep, voffB);
            PG8_WAIT_V(6); PG8_BAR; PG8_MMA(1, 1, At, B1); PG8_BAR;
            PG8_LDB(B0, 1, 0); PG8_SCHED; PG8_LDA(At, 1, 0); PG8_STAGE(PG8_SA(0, 1), a2 + hstep, voffA);
            PG8_WAIT_L(8); PG8_BAR; PG8_WAIT_L(0); PG8_MMA(0, 0, At, B0); PG8_BAR; PG8_SCHED;
            PG8_LDB(B1, 1, 1); PG8_STAGE(PG8_SB(1, 0), b3, voffB);
            PG8_BAR; PG8_WAIT_L(0); PG8_MMA(0, 1, At, B1); PG8_BAR;
            PG8_LDA(At, 1, 1); PG8_STAGE(PG8_SA(1, 0), a3, voffA);
            PG8_BAR; PG8_WAIT_L(0); PG8_MMA(1, 0, At, B0); PG8_BAR; PG8_SCHED;
            PG8_STAGE(PG8_SB(1, 1), b3 + hstep, voffB);
            PG8_WAIT_V(6); PG8_BAR; PG8_MMA(1, 1, At, B1); PG8_BAR;
            }
        }
        if constexpr (ALIGN_EPI) { if (wr == 0) PG8_BAR; }
        if constexpr (!Epi::AFTER_DRAIN) { E(acc, cur, wr, wc, fr, fq); S.done(cur); }
        if (!has_next) break;
#pragma unroll
        for (int a = 0; a < 2; ++a)
#pragma unroll
            for (int b = 0; b < 2; ++b)
#pragma unroll
                for (int m = 0; m < 4; ++m)
#pragma unroll
                    for (int n = 0; n < 2; ++n) acc[a][b][m][n] = (f32x4){0.f, 0.f, 0.f, 0.f};
        cur = nxt; cA = nA; cB = nB; ++ui;
        if constexpr (ALIGN_EPI) { if (wr == 1) PG8_BAR; }
    }
    PG8_WAIT_V(0);
    if constexpr (!ALIGN_EPI) { if (wr == 0) PG8_BAR; }
    PG8_BAR;
    if constexpr (Epi::AFTER_DRAIN) { E.fused(acc, cur, wr, wc, fr, fq, lds, wid, lane); S.done(cur); }
#undef PG8_SA
#undef PG8_SB
#undef PG8_STAGE
#undef PG8_LDA
#undef PG8_LDB
#undef PG8_MMA
#undef PG8_WAIT_V
#undef PG8_WAIT_L
#undef PG8_BAR
#undef PG8_SCHED
}
}

namespace att {
using bf16x8 = __attribute__((ext_vector_type(8))) short;
using s16x4  = __attribute__((ext_vector_type(4))) short;
using f32x16 = __attribute__((ext_vector_type(16))) float;
using u32x4  = __attribute__((ext_vector_type(4))) unsigned;
constexpr int NW = 8, QBLK = 32, KVBLK = 64;
#ifndef ATT_NQREG
#define ATT_NQREG 3
#endif
#ifndef QKT_PIN
#define QKT_PIN 1
#endif
#ifndef QKT_PIN_MASK
#define QKT_PIN_MASK 3
#endif
constexpr int NQREG = ATT_NQREG, NQLDS = 12 - NQREG;
constexpr float SCALE = 0.07216878364870322f;
constexpr float THR = 8.f;
constexpr int LDQ = 3072, LDK = 4096, LDR = 64, LDO = 2048;
constexpr int SHM_V = KVBLK * 128 * 2, SHM_K = KVBLK * 128 * 2, SHM_R = KVBLK * 64 * 2;
constexpr int OFF_V = 0, OFF_K = 2 * SHM_V, OFF_R = OFF_K + 2 * SHM_K, OFF_WS = OFF_R + 2 * SHM_R, OFF_QR = OFF_WS + NW * 64 * 4, SHM_ATTN = OFF_QR + NW * NQLDS * 1024;
#define KSWZ(row, colB) ((row) * 256 + ((colB) ^ (((row) & 7) << 4)))
#define RSWZ(row, ch) ((row) * 128 + ((((ch) ^ (((row) >> 1) & 7))) << 4))
#define SBAR() __builtin_amdgcn_sched_barrier(0)
__device__ __forceinline__ int crow(int r, int hi) { return (r & 3) + 8 * (r >> 2) + 4 * hi; }
typedef float f32x2_t __attribute__((ext_vector_type(2))); typedef __bf16 bf16x2_t __attribute__((ext_vector_type(2)));
__device__ __forceinline__ unsigned cvtpk(float lo, float hi) { f32x2_t v = {lo, hi}; bf16x2_t b = __builtin_convertvector(v, bf16x2_t); return __builtin_bit_cast(unsigned, b); }

__device__ __forceinline__ void partialSM(f32x16& p0, f32x16& p1, float& m_reg, float& mn, float& alpha) {
  constexpr float C = SCALE * 1.4426950408889634f;
  float pmax = p0[0];
#pragma unroll
  for (int r = 1; r < 16; ++r) pmax = fmaxf(pmax, p0[r]);
#pragma unroll
  for (int r = 0; r < 16; ++r) pmax = fmaxf(pmax, p1[r]);
  { auto rr = __builtin_amdgcn_permlane32_swap(__float_as_uint(pmax), __float_as_uint(pmax), false, false);
    pmax = fmaxf(__uint_as_float(rr[0]), __uint_as_float(rr[1])); }
  if (__builtin_expect(__all(pmax - m_reg <= THR / SCALE), 1)) { mn = m_reg; alpha = 1.f; }
  else { mn = fmaxf(m_reg, pmax); alpha = __builtin_amdgcn_exp2f((m_reg - mn) * C); m_reg = mn; }
  float mnC = -mn * C;
#pragma unroll
  for (int r = 0; r < 16; ++r) p0[r] = fmaf(p0[r], C, mnC);
#pragma unroll
  for (int r = 0; r < 16; ++r) p1[r] = fmaf(p1[r], C, mnC);
#pragma unroll
  for (int r = 0; r < 16; ++r) p0[r] = __builtin_amdgcn_exp2f(p0[r]);
}
__device__ __forceinline__ void finishSM(f32x16& p0, f32x16& p1, float alpha, float& l_reg, bf16x8& pa0, bf16x8& pa1, bf16x8& pa2, bf16x8& pa3) {
#pragma unroll
  for (int r = 0; r < 16; ++r) p1[r] = __builtin_amdgcn_exp2f(p1[r]);
  float ps = 0;
#pragma unroll
  for (int r = 0; r < 16; ++r) ps += p0[r];
#pragma unroll
  for (int r = 0; r < 16; ++r) ps += p1[r];
  { auto rr = __builtin_amdgcn_permlane32_swap(__float_as_uint(ps), __float_as_uint(ps), false, false);
    ps = __uint_as_float(rr[0]) + __uint_as_float(rr[1]); }
  l_reg = l_reg * alpha + ps;
#define PK4(P, BASE, OUT) do { unsigned a0 = cvtpk(P[BASE + 0], P[BASE + 1]), a1 = cvtpk(P[BASE + 2], P[BASE + 3]);   \
    unsigned b0 = cvtpk(P[BASE + 4], P[BASE + 5]), b1 = cvtpk(P[BASE + 6], P[BASE + 7]);                              \
    auto r0 = __builtin_amdgcn_permlane32_swap(a0, b0, false, false); auto r1 = __builtin_amdgcn_permlane32_swap(a1, b1, false, false); \
    u32x4 w = {r0[0], r1[0], r0[1], r1[1]}; OUT = *reinterpret_cast<bf16x8*>(&w); } while (0)
  PK4(p0, 0, pa0); PK4(p0, 8, pa1); PK4(p1, 0, pa2); PK4(p1, 8, pa3);
#undef PK4
}
typedef LAS char* lp_t; typedef const LAS char* clp_t;
__device__ __forceinline__ void qkt(f32x16& p0, f32x16& p1, clp_t Ks, clp_t Rs, const bf16x8* qr, clp_t Qr, int r32, int hi) {
  p0 = f32x16{}; p1 = f32x16{};
#pragma unroll
  for (int d0 = 0; d0 < 8; ++d0) { int cb = (d0 * 16 + hi * 8) * 2;
    bf16x8 b0 = *(const LAS bf16x8*)(Ks + KSWZ(r32, cb));
    bf16x8 b1 = *(const LAS bf16x8*)(Ks + KSWZ(32 + r32, cb));
    bf16x8 qv; if (d0 < NQREG) qv = qr[d0]; else qv = *(const LAS bf16x8*)(Qr + (d0 - NQREG) * 1024);
    p0 = __builtin_amdgcn_mfma_f32_32x32x16_bf16(b0, qv, p0, 0, 0, 0);
    p1 = __builtin_amdgcn_mfma_f32_32x32x16_bf16(b1, qv, p1, 0, 0, 0);
    if (QKT_PIN && (d0 & (QKT_PIN_MASK)) == (QKT_PIN_MASK)) SBAR(); }
#pragma unroll
  for (int d0 = 0; d0 < 4; ++d0) { int ch = d0 * 2 + hi;
    bf16x8 b0 = *(const LAS bf16x8*)(Rs + RSWZ(r32, ch));
    bf16x8 b1 = *(const LAS bf16x8*)(Rs + RSWZ(32 + r32, ch));
    bf16x8 qv; if (8 + d0 < NQREG) qv = qr[8 + d0]; else qv = *(const LAS bf16x8*)(Qr + (8 + d0 - NQREG) * 1024);
    p0 = __builtin_amdgcn_mfma_f32_32x32x16_bf16(b0, qv, p0, 0, 0, 0);
    p1 = __builtin_amdgcn_mfma_f32_32x32x16_bf16(b1, qv, p1, 0, 0, 0); }
}
__device__ __forceinline__ int v_st(int k, int c) { const int kk = (k & ~0xC) | ((k & 4) << 1) | ((k & 8) >> 1); return ((kk >> 3) * 4 + (c >> 5)) * 512 + ((kk & 7) * 32 + (c & 31)) * 2; }
__device__ __forceinline__ int v_rd_base(int lane) { return ((lane & 3) << 3) | (((lane >> 2) & 3) << 6) | (((lane >> 4) & 1) << 5) | (((lane >> 5) & 1) << 8); }
constexpr int v_rd_off(int d0, int ks, int half) { return d0 * 512 + ks * 4096 + half * 2048; }
template <int OFF> __device__ __forceinline__ s16x4 tr_read(int vb) {
  s16x4 r; asm volatile("ds_read_b64_tr_b16 %0, %1 offset:%2" : "=&v"(r) : "v"(vb), "i"(OFF) : "memory"); return r;
}
template <int D0> __device__ __forceinline__ void pv_one(f32x16& od, int vb, bf16x8 pa0, bf16x8 pa1, bf16x8 pa2, bf16x8 pa3) {
  const s16x4 l0 = tr_read<v_rd_off(D0, 0, 0)>(vb), h0 = tr_read<v_rd_off(D0, 0, 1)>(vb), l1 = tr_read<v_rd_off(D0, 1, 0)>(vb), h1 = tr_read<v_rd_off(D0, 1, 1)>(vb);
  const s16x4 l2 = tr_read<v_rd_off(D0, 2, 0)>(vb), h2 = tr_read<v_rd_off(D0, 2, 1)>(vb), l3 = tr_read<v_rd_off(D0, 3, 0)>(vb), h3 = tr_read<v_rd_off(D0, 3, 1)>(vb);
  asm volatile("s_waitcnt lgkmcnt(0)" ::: "memory"); SBAR();
#define PK(L, H) (bf16x8){L[0], L[1], L[2], L[3], H[0], H[1], H[2], H[3]}
  od = __builtin_amdgcn_mfma_f32_32x32x16_bf16(pa0, PK(l0, h0), od, 0, 0, 0);
  od = __builtin_amdgcn_mfma_f32_32x32x16_bf16(pa1, PK(l1, h1), od, 0, 0, 0);
  od = __builtin_amdgcn_mfma_f32_32x32x16_bf16(pa2, PK(l2, h2), od, 0, 0, 0);
  od = __builtin_amdgcn_mfma_f32_32x32x16_bf16(pa3, PK(l3, h3), od, 0, 0, 0);
#undef PK
}
__device__ __forceinline__ void pv_d0(f32x16* o, int vb, bf16x8 pa0, bf16x8 pa1, bf16x8 pa2, bf16x8 pa3) {
  pv_one<0>(o[0], vb, pa0, pa1, pa2, pa3); pv_one<1>(o[1], vb, pa0, pa1, pa2, pa3); pv_one<2>(o[2], vb, pa0, pa1, pa2, pa3); pv_one<3>(o[3], vb, pa0, pa1, pa2, pa3);
}
__device__ __forceinline__ void attn_unit(const unsigned short* __restrict__ Qb, const unsigned short* __restrict__ Kbase0, const unsigned short* __restrict__ Kn,
                                          const unsigned short* __restrict__ Kr, unsigned short* __restrict__ Ob, int seq, LAS char* lds, const int tid) {
  const int wid = __builtin_amdgcn_readfirstlane(tid >> 6), lane = tid & 63, r32 = lane & 31, hi = lane >> 5;
  lp_t V_lds = lds + OFF_V; lp_t K_lds = lds + OFF_K; lp_t R_lds = lds + OFF_R;
  LAS float* ws = (LAS float*)(lds + OFF_WS) + wid * 64; LAS float* li_l = ws; LAS float* al_l = ws + 32;
  float m_reg = -1e30f, l_reg = 0; f32x16 o[4] = {}; bf16x8 qr[NQREG > 0 ? NQREG : 1];
  const unsigned short* Qw = Qb + (long)(wid * QBLK + r32) * LDQ + hi * 8;
#pragma unroll
  for (int d0 = 0; d0 < NQREG; ++d0) qr[d0] = *reinterpret_cast<const bf16x8*>(Qw + d0 * 16);
  lp_t Qr = lds + OFF_QR + wid * (NQLDS * 1024) + (hi * 32 + r32) * 16;
#pragma unroll
  for (int d0 = NQREG; d0 < 12; ++d0) *(LAS bf16x8*)(Qr + (d0 - NQREG) * 1024) = *reinterpret_cast<const bf16x8*>(Qw + d0 * 16);
  const int sr = tid >> 4, sc = (tid & 15) * 8, vst0 = v_st(sr, sc), vst1 = v_st(32 + sr, sc);
  const int rk = tid >> 3, rch = tid & 7, rst = RSWZ(rk, rch);
  const int vb0 = (int)(unsigned)(uintptr_t)V_lds + v_rd_base(lane);
  bf16x8 vs0, vs1, ks0, ks1, rs0;
  const __amdgpu_buffer_rsrc_t srdKV = __builtin_amdgcn_make_buffer_rsrc((void*)Kn, (short)0, (int)(((long)seq * LDK - (Kn - Kbase0)) * 2), 0x00020000);
  const __amdgpu_buffer_rsrc_t srdR = __builtin_amdgcn_make_buffer_rsrc((void*)Kr, (short)0, (int)((long)seq * LDR * 2), 0x00020000);
  const int voffKV = (sr * LDK + sc) * 2, voffR = (rk * LDR + rch * 8) * 2;
#define BLD(srd, vo, so) __builtin_bit_cast(bf16x8, __builtin_amdgcn_raw_buffer_load_b128(srd, vo, so, 0))
#define SLOAD(k0) do { const int so_ = __builtin_amdgcn_readfirstlane((k0) * LDK * 2); \
    vs0 = BLD(srdKV, voffKV + 256, so_); vs1 = BLD(srdKV, voffKV + 256, so_ + 32 * LDK * 2); \
    ks0 = BLD(srdKV, voffKV, so_); ks1 = BLD(srdKV, voffKV, so_ + 32 * LDK * 2); \
    rs0 = BLD(srdR, voffR, __builtin_amdgcn_readfirstlane((k0) * LDR * 2)); } while (0)
#define SWRITE(b) do { *(LAS bf16x8*)(V_lds + (b) * SHM_V + vst0) = vs0; *(LAS bf16x8*)(V_lds + (b) * SHM_V + vst1) = vs1; int kc = sc * 2; \
    *(LAS bf16x8*)(K_lds + (b) * SHM_K + KSWZ(sr, kc)) = ks0; *(LAS bf16x8*)(K_lds + (b) * SHM_K + KSWZ(32 + sr, kc)) = ks1; \
    *(LAS bf16x8*)(R_lds + (b) * SHM_R + rst) = rs0; } while (0)
#define SWAIT() asm volatile("s_waitcnt vmcnt(0)" ::: "memory")
#define RESC(a) do { if (__any((a) < 1.f)) { if (hi == 0) al_l[r32] = (a); asm volatile("s_waitcnt lgkmcnt(0)" ::: "memory"); \
    _Pragma("unroll") for (int d = 0; d < 4; ++d) _Pragma("unroll") for (int r = 0; r < 16; ++r) o[d][r] *= al_l[crow(r, hi)]; } } while (0)
  f32x16 pA0, pA1, pB0, pB1; float mnA, mnB, alA, alB; bf16x8 pa0, pa1, pa2, pa3; const int NT = seq / KVBLK;
  SLOAD(0); SWAIT(); SWRITE(0); __syncthreads();
  qkt(pA0, pA1, K_lds, R_lds, qr, Qr, r32, hi); partialSM(pA0, pA1, m_reg, mnA, alA);
  SLOAD(KVBLK);
  SWAIT(); SWRITE(1); __syncthreads();
  for (int j = 1; j + 1 < NT; j += 2) {
    SBAR(); qkt(pB0, pB1, K_lds + SHM_K, R_lds + SHM_R, qr, Qr, r32, hi);
    finishSM(pA0, pA1, alA, l_reg, pa0, pa1, pa2, pa3); SBAR();
    SLOAD((j + 1) * KVBLK); SBAR();
    pv_d0(o, vb0, pa0, pa1, pa2, pa3); partialSM(pB0, pB1, m_reg, mnB, alB);
    __syncthreads(); SWAIT(); SWRITE(0);
    RESC(alB); __syncthreads();
    SBAR(); qkt(pA0, pA1, K_lds, R_lds, qr, Qr, r32, hi);
    finishSM(pB0, pB1, alB, l_reg, pa0, pa1, pa2, pa3); SBAR();
    SLOAD((j + 2) * KVBLK); SBAR();
    pv_d0(o, vb0 + SHM_V, pa0, pa1, pa2, pa3); partialSM(pA0, pA1, m_reg, mnA, alA);
    __syncthreads(); SWAIT(); SWRITE(1);
    RESC(alA); __syncthreads();
  }
  SBAR(); qkt(pB0, pB1, K_lds + SHM_K, R_lds + SHM_R, qr, Qr, r32, hi);
  finishSM(pA0, pA1, alA, l_reg, pa0, pa1, pa2, pa3); SBAR();
  pv_d0(o, vb0, pa0, pa1, pa2, pa3); partialSM(pB0, pB1, m_reg, mnB, alB);
  __syncthreads(); RESC(alB);
  finishSM(pB0, pB1, alB, l_reg, pa0, pa1, pa2, pa3); SBAR();
  pv_d0(o, vb0 + SHM_V, pa0, pa1, pa2, pa3);
  if (hi == 0) li_l[r32] = l_reg; asm volatile("s_waitcnt lgkmcnt(0)" ::: "memory");
  float rli[16];
#pragma unroll
  for (int r = 0; r < 16; ++r) rli[r] = __builtin_amdgcn_rcpf(li_l[crow(r, hi)]);
  unsigned short* Ow = Ob + (long)(wid * QBLK) * LDO;
#pragma unroll
  for (int r = 0; r < 16; ++r) { int orow = crow(r, hi);
#pragma unroll
    for (int d0 = 0; d0 < 4; ++d0) Ow[(long)orow * LDO + d0 * 32 + r32] = (unsigned short)(cvtpk(o[d0][r] * rli[r], 0.f) & 0xffffu); }
  __syncthreads();
#undef SLOAD
#undef BLD
#undef SWRITE
#undef SWAIT
#undef RESC
}
#undef KSWZ
#undef RSWZ
#undef SBAR
}

#define HD __device__ __forceinline__
#if defined(__HIPCC__)
typedef float cplx __attribute__((ext_vector_type(2)));
HD cplx mkc(float a, float b) { cplx r; r.x = a; r.y = b; return r; }
#endif
constexpr int FFT_M = 8192;
constexpr int FFT_BUF = 8704;
HD int fpad(int i) { return i + 2 * (i >> 5); }
HD int rev13(unsigned k) {
#if defined(__HIP_DEVICE_COMPILE__)
    return (int)(__brev(k) >> 19);
#else
    unsigned r = 0; for (int b = 0; b < 13; ++b) r |= ((k >> b) & 1u) << (12 - b); return (int)r;
#endif
}
HD void cs_rev(float rev, float& c, float& s) {
#if defined(__HIP_DEVICE_COMPILE__)
    c = __builtin_amdgcn_cosf(rev); s = __builtin_amdgcn_sinf(rev);
#else
    c = (float)cos(6.283185307179586 * (double)rev); s = (float)sin(6.283185307179586 * (double)rev);
#endif
}
HD cplx cmulf(cplx a, cplx b) { return mkc(a.x * b.x - a.y * b.y, a.x * b.y + a.y * b.x); }

template <int SHIFT, int S0, bool INV, typename BufT>
HD void fft_pass16(int tid, BufT buf) {
#if defined(__HIP_DEVICE_COMPILE__)
    asm volatile("" : "+v"(tid));
#endif
    const int lo = tid & ((1 << SHIFT) - 1);
    const int base = ((tid >> SHIFT) << (SHIFT + 4)) | lo;
    cplx r[16];
#pragma unroll
    for (int j = 0; j < 16; ++j) r[j] = buf[fpad(base + (j << SHIFT))];
    if (!INV) {
#pragma unroll
        for (int ss = 0; ss < 4; ++ss) {
            const int hj = 8 >> ss;
#pragma unroll
            for (int j = 0; j < 16; ++j) {
                if (j & hj) continue;
                const int e = (lo + ((j & (hj - 1)) << SHIFT)) << (S0 + ss);
                float c, s; cs_rev((float)e * (1.0f / FFT_M), c, s);
                const cplx a = r[j], b = r[j + hj];
                r[j] = mkc(a.x + b.x, a.y + b.y);
                const cplx d = mkc(a.x - b.x, a.y - b.y);
                r[j + hj] = cmulf(d, mkc(c, -s));
            }
        }
    } else {
#pragma unroll
        for (int ss = 3; ss >= 0; --ss) {
            const int hj = 8 >> ss;
#pragma unroll
            for (int j = 0; j < 16; ++j) {
                if (j & hj) continue;
                const int e = (lo + ((j & (hj - 1)) << SHIFT)) << (S0 + ss);
                float c, s; cs_rev((float)e * (1.0f / FFT_M), c, s);
                const cplx t = cmulf(r[j + hj], mkc(c, s));
                const cplx a = r[j];
                r[j] = mkc(a.x + t.x, a.y + t.y);
                r[j + hj] = mkc(a.x - t.x, a.y - t.y);
            }
        }
    }
#pragma unroll
    for (int j = 0; j < 16; ++j) buf[fpad(base + (j << SHIFT))] = r[j];
}
template <typename BufT>
HD void fft_pass_last(int tid, BufT buf) {
#pragma unroll
    for (int q = 0; q < 8; ++q) {
        const int i = 2 * (tid + 512 * q), p = fpad(i);
        const cplx a = buf[p], b = buf[p + 1];
        buf[p] = mkc(a.x + b.x, a.y + b.y);
        buf[p + 1] = mkc(a.x - b.x, a.y - b.y);
    }
}
template <typename BufT>
HD void fft_combine(int tid, BufT A, BufT B) {
#if defined(__HIP_DEVICE_COMPILE__)
    asm volatile("" : "+v"(tid));
#endif
#pragma unroll 1
    for (int q = 0; q < 9; ++q) {
        const int k = tid + 512 * q;
        if (k > FFT_M / 2) break;
        const int pk = fpad(rev13((unsigned)k)), pm = fpad(rev13((unsigned)((FFT_M - k) & (FFT_M - 1))));
        const cplx za = A[pk], zb = A[pm], ha = B[pk], hb = B[pm];
        float c, s; cs_rev((float)k * (1.0f / (2 * FFT_M)), c, s);
        const cplx w = mkc(c, -s);
        const cplx Ex = mkc(0.5f * (za.x + zb.x), 0.5f * (za.y - zb.y));
        const cplx Dx = mkc(za.x - zb.x, za.y + zb.y);
        const cplx Ox = mkc(0.5f * Dx.y, -0.5f * Dx.x);
        const cplx Eh = mkc(0.5f * (ha.x + hb.x), 0.5f * (ha.y - hb.y));
        const cplx Dh = mkc(ha.x - hb.x, ha.y + hb.y);
        const cplx Oh = mkc(0.5f * Dh.y, -0.5f * Dh.x);
        const cplx wOx = cmulf(w, Ox), wOh = cmulf(w, Oh);
        const cplx X1 = mkc(Ex.x + wOx.x, Ex.y + wOx.y), X2 = mkc(Ex.x - wOx.x, Ex.y - wOx.y);
        const cplx H1 = mkc(Eh.x + wOh.x, Eh.y + wOh.y), H2 = mkc(Eh.x - wOh.x, Eh.y - wOh.y);
        const cplx Y1 = cmulf(X1, H1), Y2 = cmulf(X2, H2);
        const cplx Ey = mkc(0.5f * (Y1.x + Y2.x), 0.5f * (Y1.y + Y2.y));
        const cplx Dy = mkc(0.5f * (Y1.x - Y2.x), 0.5f * (Y1.y - Y2.y));
        const cplx Oy = cmulf(Dy, mkc(c, s));
        A[pk] = mkc(Ey.x - Oy.y, Ey.y + Oy.x);
        if (k != 0 && k != FFT_M / 2) A[pm] = mkc(Ey.x + Oy.y, -Ey.y + Oy.x);
    }
}
template <typename BufT>
HD void fft_put16(int tid, BufT buf, const float* x16) {
#pragma unroll
    for (int q = 0; q < 8; ++q) {
        buf[fpad(8 * tid + q)] = mkc(x16[2 * q], x16[2 * q + 1]);
        buf[fpad(4096 + 8 * tid + q)] = mkc(0.f, 0.f);
    }
}
template <typename BufT>
HD void fft_get16_mid(int tid, BufT buf, float* y16) {
#pragma unroll
    for (int q = 0; q < 8; ++q) { const cplx f = buf[fpad(2048 + 8 * tid + q)]; y16[2 * q] = f.x; y16[2 * q + 1] = f.y; }
}

typedef LAS cplx* lbuf_t;
__device__ __forceinline__ void fft_fwd2(int tid, lbuf_t A, lbuf_t B) {
    __syncthreads();
    fft_pass16<9, 0, false>(tid, A); __builtin_amdgcn_sched_barrier(0); fft_pass16<9, 0, false>(tid, B); __syncthreads();
    fft_pass16<5, 4, false>(tid, A); __builtin_amdgcn_sched_barrier(0); fft_pass16<5, 4, false>(tid, B); __syncthreads();
    fft_pass16<1, 8, false>(tid, A); __builtin_amdgcn_sched_barrier(0); fft_pass16<1, 8, false>(tid, B); __syncthreads();
    fft_pass_last(tid, A); fft_pass_last(tid, B); __syncthreads();
}
__device__ __forceinline__ void fft_inv1(int tid, lbuf_t A) {
    fft_pass_last(tid, A); __syncthreads();
    fft_pass16<1, 8, true>(tid, A); __syncthreads();
    fft_pass16<5, 4, true>(tid, A); __syncthreads();
    fft_pass16<9, 0, true>(tid, A); __syncthreads();
}
__device__ __forceinline__ void shortconv16(const bf16* hyT, int ch, int tid, const float* conv_w, const float* conv_b, float* out) {
    const bf16* p = hyT + (size_t)ch * 8192 + 16 * tid;
    const v4u a = *(const v4u*)p, b = *(const v4u*)(p + 8);
    float u[18];
    u[0] = tid > 0 ? bf2f(p[-1]) : 0.f; u[17] = tid < 511 ? bf2f(p[16]) : 0.f;
    const unsigned w[8] = {a.x, a.y, a.z, a.w, b.x, b.y, b.z, b.w};
#pragma unroll
    for (int i = 0; i < 8; ++i) { u[1 + 2 * i] = __builtin_bit_cast(float, w[i] << 16); u[2 + 2 * i] = __builtin_bit_cast(float, w[i] & 0xffff0000u); }
    const float w0 = conv_w[ch], w1 = conv_w[3072 + ch], w2 = conv_w[6144 + ch], bb = conv_b[ch];
#pragma unroll
    for (int i = 0; i < 16; ++i) out[i] = w0 * u[i] + w1 * u[i + 1] + w2 * u[i + 2] + bb;
}
__device__ __forceinline__ float block_sum512(float v, LAS float* red, int tid) {
    v = wave_sum(v);
    if ((tid & 63) == 0) red[tid >> 6] = v;
    __syncthreads();
    float s = 0.f;
#pragma unroll
    for (int i = 0; i < 8; ++i) s += red[i];
    __syncthreads();
    return s;
}
__device__ __forceinline__ void hyena_unit(int c, const bf16* hyT, const float* conv_w, const float* conv_b, const float* hfilt, const float* skip, bf16* hyo, LAS unsigned char* lds, const int tid) {
    lbuf_t A = (lbuf_t)lds, B = (lbuf_t)(lds + FFT_BUF * 8);
    LAS float* red = (LAS float*)(lds + 2 * FFT_BUF * 8);
    float v[16], y[16], g[16];
    float ss = 0.f;
    { const float* hp = hfilt + (size_t)c * 8192 + 16 * tid;
#pragma unroll
      for (int i = 0; i < 4; ++i) { const v4f h4 = *(const v4f*)(hp + 4 * i); g[4 * i] = h4[0]; g[4 * i + 1] = h4[1]; g[4 * i + 2] = h4[2]; g[4 * i + 3] = h4[3]; }
#pragma unroll
      for (int i = 0; i < 16; ++i) ss += g[i] * g[i]; }
    fft_put16(tid, B, g);
    shortconv16(hyT, c, tid, conv_w, conv_b, v);
    fft_put16(tid, A, v);
    const float rn0 = (1.0f / sqrtf(block_sum512(ss, red, tid) + 1e-6f)) * (1.0f / FFT_M);
    fft_fwd2(tid, A, B);
    fft_combine(tid, A, B); __syncthreads();
    fft_inv1(tid, A);
    fft_get16_mid(tid, A, y);
    shortconv16(hyT, 1024 + c, tid, conv_w, conv_b, g);
    const float sk0 = skip[c], sk1 = skip[1024 + c];
#pragma unroll
    for (int i = 0; i < 16; ++i) v[i] = g[i] * (y[i] * rn0 + sk0 * v[i]);
    __syncthreads();
    ss = 0.f;
    { const float* hp = hfilt + (size_t)(1024 + c) * 8192 + 16 * tid;
#pragma unroll
      for (int i = 0; i < 4; ++i) { const v4f h4 = *(const v4f*)(hp + 4 * i); g[4 * i] = h4[0]; g[4 * i + 1] = h4[1]; g[4 * i + 2] = h4[2]; g[4 * i + 3] = h4[3]; }
#pragma unroll
      for (int i = 0; i < 16; ++i) ss += g[i] * g[i]; }
    fft_put16(tid, B, g);
    fft_put16(tid, A, v);
    const float rn1 = (1.0f / sqrtf(block_sum512(ss, red, tid) + 1e-6f)) * (1.0f / FFT_M);
    fft_fwd2(tid, A, B);
    fft_combine(tid, A, B); __syncthreads();
    fft_inv1(tid, A);
    fft_get16_mid(tid, A, y);
    shortconv16(hyT, 2048 + c, tid, conv_w, conv_b, g);
    v4u o0, o1;
    float r[16];
#pragma unroll
    for (int i = 0; i < 16; ++i) r[i] = g[i] * (y[i] * rn1 + sk1 * v[i]);
    o0.x = pk2(r[0], r[1]); o0.y = pk2(r[2], r[3]); o0.z = pk2(r[4], r[5]); o0.w = pk2(r[6], r[7]);
    o1.x = pk2(r[8], r[9]); o1.y = pk2(r[10], r[11]); o1.z = pk2(r[12], r[13]); o1.w = pk2(r[14], r[15]);
    bf16* op = hyo + (size_t)c * 8192 + 16 * tid;
    *(v4u*)op = o0; *(v4u*)(op + 8) = o1;
    __syncthreads();
}

template <class ColFn>
__device__ __forceinline__ void cvt_item(const float* W, int K, int N, bf16* WT, int nblk, ColFn col, const float* kscale, LAS float* scr, int item, int lane) {
    const int kb = item / nblk, nb = item % nblk, k0 = 64 * kb, n0 = 32 * nb;
    const int src = col(n0 + (lane & 31));
#pragma unroll 8
    for (int i = 0; i < 32; ++i) { const int kk = 2 * i + (lane >> 5); float val = src >= 0 ? W[(size_t)(k0 + kk) * N + src] : 0.f; if (kscale) val *= kscale[k0 + kk]; scr[kk * 33 + (lane & 31)] = val; }
    LDS_WAIT(); asm volatile("" ::: "memory");
    const int c = lane & 7;
#pragma unroll
    for (int j = 0; j < 4; ++j) { const int n = (lane >> 3) + 8 * j; const LAS float* s = scr + (8 * c) * 33 + n;
        v4u o; o.x = pk2(s[0 * 33], s[1 * 33]); o.y = pk2(s[2 * 33], s[3 * 33]); o.z = pk2(s[4 * 33], s[5 * 33]); o.w = pk2(s[6 * 33], s[7 * 33]);
        *(v4u*)(WT + (size_t)(n0 + n) * K + k0 + 8 * c) = o; }
    LDS_WAIT(); asm volatile("" ::: "memory");
}
struct ColId { __device__ __forceinline__ int operator()(int n) const { return n; } };
struct ColW13 { __device__ __forceinline__ int operator()(int n) const { return ((n & 255) >> 7) * 5632 + (n >> 8) * 128 + (n & 127); } };
__device__ __forceinline__ int rope_src(int j) { const int grp = j >> 5, jj = j & 31; return grp * 32 + (jj & 1) * 16 + (jj >> 1); }
struct ColWin { __device__ __forceinline__ int operator()(int n) const {
    if (n < 1024) return n; if (n < 4096) return 1088 + (n - 1024); if (n < 8192) return 4160 + (n - 4096); if (n < 8256) return 1024 + rope_src(n - 8192); return -1; } };
struct ColWuq { __device__ __forceinline__ int operator()(int n) const { const int h = n / 192, w = n - h * 192; return w < 128 ? n : h * 192 + 128 + rope_src(w - 128); } };

__device__ __forceinline__ void mod_unit(int unit, const float* w_mod, const float* b_mod, float* mods, const LAS float* sc  , LAS float* red  , int tid) {
    const int lane = tid & 63, wv = tid >> 6, col = unit * 64 + lane;
    float a0 = 0.f, a1 = 0.f;
    const float* wp = w_mod + (size_t)(wv * 256) * 18432 + col;
#pragma unroll 16
    for (int k = 0; k < 256; ++k) { const float w = wp[(size_t)k * 18432]; a0 += sc[wv * 256 + k] * w; a1 += sc[2048 + wv * 256 + k] * w; }
    red[(wv * 2 + 0) * 64 + lane] = a0; red[(wv * 2 + 1) * 64 + lane] = a1;
    __syncthreads();
    if (tid < 128) { const int v = tid >> 6; float s = b_mod[col];
#pragma unroll
        for (int w = 0; w < 8; ++w) s += red[(w * 2 + v) * 64 + lane];
        mods[v * 18432 + col] = s; }
    __syncthreads();
}
__device__ __forceinline__ void filter_unit(int unit, const float* w1, const float* b1, const float* w2, const float* b2, const float* w3, const float* freq, float* hfilt, LAS float* Z  , LAS float* H1  , LAS float* H2  , int tid) {
    const int t0 = (unit >> 2) * 64, oq = unit & 3, lane = tid & 63, wv = tid >> 6;
#pragma unroll 1
    for (int idx = tid; idx < 33 * 64; idx += 512) {
        const int i = idx >> 6, t = t0 + (idx & 63); float val;
        if (i == 0) val = (float)t / 8191.0f;
        else { const int b = (i - 1) & 15; const double band = 1e-4 + (double)b * ((15.0 - 1e-4) / 15.0); double rv = band * (double)t * (1.0 / 8192.0); rv -= floor(rv);
               const float ang = 6.283185307179586f * (float)rv; val = i <= 16 ? cosf(ang) : -sinf(ang); }
        Z[idx] = val;
    }
    __syncthreads();
    {   float acc[8];
#pragma unroll
        for (int q = 0; q < 8; ++q) acc[q] = b1[wv * 8 + q];
#pragma unroll 1
        for (int i = 0; i < 33; ++i) { const float zv = Z[i * 64 + lane];
#pragma unroll
            for (int q = 0; q < 8; ++q) acc[q] += zv * w1[i * 64 + wv * 8 + q]; }
#pragma unroll
        for (int q = 0; q < 8; ++q) H1[(wv * 8 + q) * 64 + lane] = sinf(freq[wv * 8 + q] * acc[q]);
    }
    __syncthreads();
    {   float acc[8];
#pragma unroll
        for (int q = 0; q < 8; ++q) acc[q] = b2[wv * 8 + q];
#pragma unroll 2
        for (int i = 0; i < 64; ++i) { const float hv = H1[i * 64 + lane];
#pragma unroll
            for (int q = 0; q < 8; ++q) acc[q] += hv * w2[i * 64 + wv * 8 + q]; }
#pragma unroll
        for (int q = 0; q < 8; ++q) H2[(wv * 8 + q) * 64 + lane] = sinf(freq[wv * 8 + q] * acc[q]);
    }
    __syncthreads();
    const int t = t0 + lane; const float dist = fabsf((float)t - 4096.0f) * (1.0f / 4096.0f);
#pragma unroll 1
    for (int it = 0; it < 8; ++it) {
        const int oc0 = oq * 512 + wv * 64 + it * 8; float acc[8];
#pragma unroll
        for (int q = 0; q < 8; ++q) acc[q] = 0.f;
#pragma unroll 2
        for (int j = 0; j < 64; ++j) { const float hv = H2[j * 64 + lane];
#pragma unroll
            for (int q = 0; q < 8; ++q) acc[q] += hv * w3[j * 2048 + oc0 + q]; }
#pragma unroll
        for (int q = 0; q < 8; ++q) { const int oc = oc0 + q, ch = oc & 1023;
            const float decay = fabsf(-3.0701134573253944f + (-15.350567286626973f + 3.0701134573253944f) * ((float)ch * (1.0f / 1023.0f)));
            hfilt[(size_t)oc * 8192 + t] = acc[q] * (__expf(-dist * decay) + 0.05f); }
    }
    __syncthreads();
}
__device__ __forceinline__ void norm_row_bf16(const float* xrow, const float* g, const float* shift, const float* scale, bf16* orow, int lane) {
    const v4f* xr = (const v4f*)xrow + lane; v4f v[8]; float s = 0.f;
#pragma unroll
    for (int j = 0; j < 8; ++j) { v[j] = xr[64 * j]; s += (v[j][0] * v[j][0] + v[j][1] * v[j][1]) + (v[j][2] * v[j][2] + v[j][3] * v[j][3]); }
    const float rstd = 1.0f / sqrtf(wave_sum(s) * (1.0f / 2048.0f) + 1e-6f);
    v2u* o8 = (v2u*)orow + lane;
#pragma unroll
    for (int j = 0; j < 8; ++j) { const v4f gg = ((const v4f*)g)[lane + 64 * j], sh = ((const v4f*)shift)[lane + 64 * j], scl = ((const v4f*)scale)[lane + 64 * j];
        const v4f y = v[j] * rstd * gg * (scl + 1.0f) + sh; v2u w; w.x = pk2(y[0], y[1]); w.y = pk2(y[2], y[3]); o8[64 * j] = w; }
}
__device__ __forceinline__ void final_norm_row(float* xrow, const float* g, int lane) {
    v4f* xr = (v4f*)xrow + lane; v4f v[8]; float s = 0.f;
#pragma unroll
    for (int j = 0; j < 8; ++j) { v[j] = xr[64 * j]; s += (v[j][0] * v[j][0] + v[j][1] * v[j][1]) + (v[j][2] * v[j][2] + v[j][3] * v[j][3]); }
    const float rstd = 1.0f / sqrtf(wave_sum(s) * (1.0f / 2048.0f) + 1e-6f);
#pragma unroll
    for (int j = 0; j < 8; ++j) xr[64 * j] = v[j] * rstd * ((const v4f*)g)[lane + 64 * j];
}
__device__ __forceinline__ void transpose_item(const bf16* hyo, bf16* hytok, int item, LAS unsigned short* scr  , int lane) {
    const int cb = item >> 7, tb = item & 127, c0 = cb * 64, t0 = tb * 64;
#pragma unroll 8
    for (int i = 0; i < 32; ++i) { const int ch = 2 * i + (lane >> 5); const unsigned val = *(const unsigned*)(hyo + (size_t)(c0 + ch) * 8192 + t0 + 2 * (lane & 31));
        *(LAS unsigned*)(scr + ch * 66 + 2 * (lane & 31)) = val; }
    LDS_WAIT(); asm volatile("" ::: "memory");
    const int q = lane & 7;
#pragma unroll
    for (int it = 0; it < 8; ++it) { const int t = 8 * it + (lane >> 3); const LAS unsigned short* s = scr + (8 * q) * 66 + t;
        v4u o; o.x = (unsigned)s[0] | ((unsigned)s[66] << 16); o.y = (unsigned)s[2 * 66] | ((unsigned)s[3 * 66] << 16); o.z = (unsigned)s[4 * 66] | ((unsigned)s[5 * 66] << 16); o.w = (unsigned)s[6 * 66] | ((unsigned)s[7 * 66] << 16);
        *(v4u*)(hytok + (size_t)(t0 + t) * 1024 + c0 + 8 * q) = o; }
    LDS_WAIT(); asm volatile("" ::: "memory");
}


typedef GAS unsigned gu32;
__device__ __forceinline__ unsigned long long rt() { return __builtin_amdgcn_s_memrealtime(); }
#define XB_TMO      128
#define XB_XCNT(j)  (256  + 64 * (j))
#define XB_XSUB(j)  (1280 + 64 * (j))
#define XB_XGEN(j)  (2304 + 64 * (j))
#define XB_TOP      3328
#define XB_TOPGEN   3392
#define XCD_BAR_WORDS 3456
#define XB_SPIN_CAP (1u << 18)

__device__ __forceinline__ unsigned xb_ld(unsigned* p)              { return __hip_atomic_load(p, __ATOMIC_RELAXED, __HIP_MEMORY_SCOPE_AGENT); }
__device__ __forceinline__ unsigned xb_add(unsigned* p, unsigned v) { return __hip_atomic_fetch_add(p, v, __ATOMIC_RELAXED, __HIP_MEMORY_SCOPE_AGENT); }
__device__ __forceinline__ unsigned xb_xcc_id() { return (unsigned)__builtin_amdgcn_s_getreg((3 << 11) | 20) & 0xFu; }
#define XB_SPIN(cond, bar) do { unsigned _sp = 0; while (cond) { __builtin_amdgcn_s_sleep(1); \
    if ((++_sp & 255u) == 0u) { if (xb_ld(&(bar)[XB_TMO])) break; if (_sp > XB_SPIN_CAP) { atomicAdd(&(bar)[XB_TMO], 1u); break; } } } } while (0)

struct XcdBarrier {
    unsigned* bar; unsigned x;
    volatile LAS unsigned* st;
};

__device__ __forceinline__ XcdBarrier xcd_barrier_post(unsigned* bar, volatile LAS unsigned* st, const bool t0) {
    XcdBarrier b; b.bar = bar; b.x = xb_xcc_id(); b.st = st;
    if (t0) (void)xb_add(&bar[XB_XCNT(b.x)], 1u);
    return b;
}
__device__ __forceinline__ void xcd_barrier_complete(unsigned* bar, unsigned x, unsigned& nloc, unsigned& nx) {
    const unsigned G = gridDim.x * gridDim.y * gridDim.z;
    unsigned sum, cnt, mine, sp = 0u;
    for (;;) {
        sum = 0u; cnt = 0u; mine = 0u;
#pragma unroll
        for (unsigned j = 0; j < 16; ++j) { const unsigned c = xb_ld(&bar[XB_XCNT(j)]); sum += c; cnt += (c > 0u) ? 1u : 0u; mine = (j == x) ? c : mine; }
        if (sum == G) break;
        __builtin_amdgcn_s_sleep(1);
        if ((++sp & 255u) == 0u) { if (xb_ld(&bar[XB_TMO])) break; if (sp > XB_SPIN_CAP) { atomicAdd(&bar[XB_TMO], 1u); break; } }
    }
    nloc = mine > 0u ? mine : 1u; nx = cnt > 0u ? cnt : 1u;
}

__device__ __forceinline__ void xcd_barrier(const XcdBarrier& b, const bool t0) {
    asm volatile("s_waitcnt vmcnt(0)" ::: "memory");
    __syncthreads();
    if (t0) {
        unsigned* bar = b.bar;
        __builtin_amdgcn_s_waitcnt(0);
        unsigned nloc = b.st[0], nx = b.st[1];
        if (nloc == 0u) { xcd_barrier_complete(bar, b.x, nloc, nx); b.st[0] = nloc; b.st[1] = nx; }
        const unsigned old = xb_add(&bar[XB_XSUB(b.x)], 1u);
        const unsigned gen = old / nloc;
        if (old + 1u == (gen + 1u) * nloc) {
            __builtin_amdgcn_fence(__ATOMIC_RELEASE, "agent");
            asm volatile("s_waitcnt vmcnt(0)" ::: "memory");
            const unsigned og = xb_add(&bar[XB_TOP], 1u);
            const unsigned tg = og / nx;
            if (og + 1u == (tg + 1u) * nx) xb_add(&bar[XB_TOPGEN], 1u);
            else XB_SPIN(xb_ld(&bar[XB_TOPGEN]) == tg, bar);
            __builtin_amdgcn_fence(__ATOMIC_ACQUIRE, "agent");
            xb_add(&bar[XB_XGEN(b.x)], 1u);
            asm volatile("s_waitcnt vmcnt(0)" ::: "memory");
        } else {
            XB_SPIN(xb_ld(&bar[XB_XGEN(b.x)]) == gen, bar);
            __builtin_amdgcn_fence(__ATOMIC_ACQUIRE, "agent");
            asm volatile("s_waitcnt vmcnt(0)" ::: "memory");
        }
    }
    __syncthreads();
}

namespace cg = cooperative_groups;
struct Args { const float* in[31]; float* dst; unsigned char* ws; };
enum { I_X = 0, I_C, I_CTX, I_CCTX, I_WMOD, I_BMOD, I_GFFN1, I_W13A, I_W2A, I_GMIX, I_WIN, I_GQ, I_WUQ, I_GKV, I_WUKV, I_WAO, I_HCW, I_HCB, I_HW1, I_HB1, I_HW2, I_HB2, I_HW3, I_HFREQ, I_HSKIP, I_WHO, I_WOUT, I_GFFN2, I_W13B, I_W2B, I_GFINAL };

template <int PH_LO, int PH_HI>
__global__ void __launch_bounds__(512, 2) mk_fwd(Args args) {
    extern __shared__ __attribute__((aligned(16))) unsigned char lds_raw[];
    LAS unsigned char* lds = (LAS unsigned char*)lds_raw;
    const int wave = __builtin_amdgcn_readfirstlane((int)threadIdx.x >> 6);
#define PHASE_TID() const int lane = lane_id_fresh(), tid = wave * 64 + lane; (void)tid; (void)lane
    const int G = gridDim.x, bx = blockIdx.x;
    const int vcu = (G % 8 == 0) ? (bx % 8) * (G / 8) + bx / 8 : bx;
    const int gw = vcu * 8 + wave, NGW = G * 8;
    typedef const __attribute__((address_space(4))) Args* kargp_t;
    const kargp_t kp0 = (kargp_t)__builtin_amdgcn_kernarg_segment_ptr();
#define KP() ({ kargp_t p_ = kp0; asm volatile("" : "+s"(p_)); p_; })
#define WSB(off) (KP()->ws + (off))
#define INP(i) (KP()->in[i])
#define mods ((float*)WSB(WS_MODS))
#define rope ((float*)WSB(WS_ROPE))
#define qss ((float*)WSB(WS_QSS))
#define kvss ((float*)WSB(WS_KVSS))
#define W13A ((bf16*)WSB(WS_W13A))
#define W2A ((bf16*)WSB(WS_W2A))
#define WIN ((bf16*)WSB(WS_WIN))
#define WUQ ((bf16*)WSB(WS_WUQ))
#define WUKV ((bf16*)WSB(WS_WUKV))
#define WAO ((bf16*)WSB(WS_WAO))
#define WHO ((bf16*)WSB(WS_WHO))
#define WOUT ((bf16*)WSB(WS_WOUT))
#define W13B ((bf16*)WSB(WS_W13B))
#define W2B ((bf16*)WSB(WS_W2B))
#define HN ((bf16*)WSB(WS_HN))
#define ACT ((bf16*)WSB(WS_ACT))
#define X1 ((float*)WSB(WS_X1))
#define HYT ((bf16*)WSB(WS_HYT))
#define KV ((bf16*)WSB(WS_KV))
#define Q ((bf16*)WSB(WS_Q))
#define T ((float*)WSB(WS_T))
#define HYO ((bf16*)WSB(WS_HYO))
#define AX ((bf16*)WSB(WS_AX))
#define GATES ((bf16*)WSB(WS_GATES))
#define PQ ((bf16*)WSB(WS_PQ))
#define PKV ((bf16*)WSB(WS_PKV))
#define KR ((bf16*)WSB(WS_KR))
#define HYTOK ((bf16*)WSB(WS_HYTOK))
#define Y ((bf16*)WSB(WS_Y))
#define out (KP()->dst)
#define hfilt (KP()->dst)
    {   const int t0_ = wave * 64 + lane_id_fresh();
        for (int u = t0_; u < 128; u += 512) ((LAS unsigned*)(lds + LDS_CTL_OFF))[u] = 0u;
        __syncthreads(); }
    XcdBarrier bar = xcd_barrier_post((unsigned*)(kp0->ws + WS_CTL) + 4096, (volatile LAS unsigned*)(lds + LDS_CTL_OFF) + 8, wave == 0 && lane_id_fresh() == 0);
    constexpr int lo = PH_LO, hi = PH_HI;
#ifndef PHASE_MASK
#define PHASE_MASK 0x3fff
#endif
#define IN(k) ((((PHASE_MASK) >> (k)) & 1) && lo <= (k) && (k) < hi)
#define SEAM(k) do { if (IN(k) && IN((k) + 1)) { if ((k) == 0) cg::this_grid().sync(); else xcd_barrier(bar, wave == 0 && lane_id_fresh() == 0); } } while (0)

    if (IN(0)) {
        PHASE_TID();
        LAS float* sc = (LAS float*)lds; LAS float* red = (LAS float*)(lds + 16384);
        for (int i = tid; i < 4096; i += 512) { const float v = i < 2048 ? INP(I_C)[i] : INP(I_CCTX)[i - 2048]; sc[i] = v * fast_sigmoid(v); }
        __syncthreads();
        for (int u = bx; u < 288; u += G) mod_unit(u, INP(I_WMOD), INP(I_BMOD), mods, sc, red, tid);
        __syncthreads();
        if (bx == 0) for (int idx = tid; idx < 2048; idx += 512) { const int pos = idx >> 4, p = idx & 15; const float inv = powf(10000.0f, -(float)p * (1.0f / 16.0f)); const float ang = (float)pos * inv;
            rope[2 * idx] = cosf(ang); rope[2 * idx + 1] = sinf(ang); }
        {   LAS float* scr = (LAS float*)(lds + wave * 16384);
            constexpr int I13 = 32 * 352, I2 = 88 * 64, IIN = 32 * 264, IUQ = 8 * 96, IUKV = 8 * 128, IAO = 32 * 64, IHO = 16 * 64, IOUT = 32 * 64;
            constexpr int NITEMS = 2 * I13 + 2 * I2 + IIN + IUQ + IUKV + IAO + IHO + IOUT;
            for (int it = gw; it < NITEMS; it += NGW) {
                int r = it;
                if (r < I13) { cvt_item(INP(I_W13A), 2048, 11264, W13A, 352, ColW13(), nullptr, scr, r, lane); continue; } r -= I13;
                if (r < I2) { cvt_item(INP(I_W2A), 5632, 2048, W2A, 64, ColId(), nullptr, scr, r, lane); continue; } r -= I2;
                if (r < IIN) { cvt_item(INP(I_WIN), 2048, 8256, WIN, 264, ColWin(), nullptr, scr, r, lane); continue; } r -= IIN;
                if (r < IUQ) { cvt_item(INP(I_WUQ), 512, 3072, WUQ, 96, ColWuq(), INP(I_GQ), scr, r, lane); continue; } r -= IUQ;
                if (r < IUKV) { cvt_item(INP(I_WUKV), 512, 4096, WUKV, 128, ColId(), INP(I_GKV), scr, r, lane); continue; } r -= IUKV;
                if (r < IAO) { cvt_item(INP(I_WAO), 2048, 2048, WAO, 64, ColId(), nullptr, scr, r, lane); continue; } r -= IAO;
                if (r < IHO) { cvt_item(INP(I_WHO), 1024, 2048, WHO, 64, ColId(), nullptr, scr, r, lane); continue; } r -= IHO;
                if (r < IOUT) { cvt_item(INP(I_WOUT), 2048, 2048, WOUT, 64, ColId(), nullptr, scr, r, lane); continue; } r -= IOUT;
                if (r < I13) { cvt_item(INP(I_W13B), 2048, 11264, W13B, 352, ColW13(), nullptr, scr, r, lane); continue; } r -= I13;
                cvt_item(INP(I_W2B), 5632, 2048, W2B, 64, ColId(), nullptr, scr, r, lane);
            }
        }
        __syncthreads();
        for (int u = bx; u < 512; u += G)
            filter_unit(u, INP(I_HW1), INP(I_HB1), INP(I_HW2), INP(I_HB2), INP(I_HW3), INP(I_HFREQ), hfilt, (LAS float*)lds, (LAS float*)(lds + 16384), (LAS float*)(lds + 32768), tid);
    }
    SEAM(0);
    if (IN(1)) {
        PHASE_TID();
        for (int row = gw; row < MTOT; row += NGW) {
            const bool isc = row >= SEQ; const float* src = isc ? INP(I_CTX) + (size_t)(row - SEQ) * DM : INP(I_X) + (size_t)row * DM; const float* mv = mods + (isc ? 18432 : 0);
            norm_row_bf16(src, INP(I_GFFN1), mv + 0 * DM, mv + 1 * DM, HN + (size_t)row * DM, lane);
        }
    }
    SEAM(1);
    if (IN(2)) {
        PHASE_TID();
        pg8::Gemm g{HN, W13A, MTOT, 11264, 2048}; pg8::StaticOrder S; S.init(MTOT, 11264, G, bx);
        pg8::EpiSwiGLU E{ACT, DFF};
        pg8::gemm_phase<pg8::EpiSwiGLU, pg8::StaticOrder, true, true>(lds, g, S, E, tid);
    }
    SEAM(2);
    if (IN(3)) {
        PHASE_TID();
        pg8::Gemm g{ACT, W2A, MTOT, 2048, DFF}; pg8::StaticOrder S; S.init(MTOT, 2048, G, bx);
        pg8::EpiResid E{INP(I_X), INP(I_CTX), mods + 2 * DM, mods + 18432 + 2 * DM, X1, 0.5f};
        pg8::gemm_phase<pg8::EpiResid, pg8::StaticOrder, true, true>(lds, g, S, E, tid);
    }
    SEAM(3);
    if (IN(4)) {
        PHASE_TID();
        for (int row = gw; row < MTOT; row += NGW) {
            const float* mv = mods + (row >= SEQ ? 18432 : 0);
            norm_row_bf16(X1 + (size_t)row * DM, INP(I_GMIX), mv + 3 * DM, mv + 4 * DM, HN + (size_t)row * DM, lane);
        }
    }
    SEAM(4);
    if (IN(5)) {
        PHASE_TID();
        pg8::Gemm g{HN, WIN, MTOT, NINP, 2048}; pg8::InProjOrder S; S.init(G, bx);
        pg8::EpiInProj E{PQ, PKV, KR, HYT, GATES, qss, kvss, rope};
        pg8::gemm_phase<pg8::EpiInProj, pg8::InProjOrder, true, true>(lds, g, S, E, tid);
    }
    SEAM(5);
    if (IN(6)) {
        PHASE_TID();
        {   pg8::Gemm g{PQ, WUQ, SEQ, 3072, 512}; pg8::StaticOrder S; S.init(SEQ, 3072, G, bx);
            pg8::EpiQUp E{Q, qss, rope};
            pg8::gemm_phase<pg8::EpiQUp, pg8::StaticOrder, true, true>(lds, g, S, E, tid); }
        {   pg8::Gemm g{PKV, WUKV, MTOT, 4096, 512}; pg8::StaticOrder S; S.init(MTOT, 4096, G, bx);
            pg8::EpiKVUp E{KV, kvss};
            pg8::gemm_phase<pg8::EpiKVUp, pg8::StaticOrder, true, true>(lds, g, S, E, tid); }
        __syncthreads();
        for (int c = bx; c < HYW; c += G) hyena_unit(c, HYT, INP(I_HCW), INP(I_HCB), hfilt, INP(I_HSKIP), HYO, lds, tid);
    }
    SEAM(6);
    if (IN(7)) {
        PHASE_TID();
        for (int i = 0; ; ++i) {
            const int u = i * G + vcu; if (u >= HEADS * (SEQ / 256)) break;
            const int head = u >> 5, qb = u & 31;
            { const bf16* kvb = KV; att::attn_unit(Q + (size_t)(qb * 256) * 3072 + head * DQH, kvb, kvb + head * 256, KR, AX + (size_t)(qb * 256) * DM + head * DVH, MTOT, (LAS char*)lds, tid); }
        }
        __syncthreads();
        LAS unsigned short* scr = (LAS unsigned short*)(lds + wave * 16384);
        for (int it = gw; it < 2048; it += NGW) transpose_item(HYO, HYTOK, it, scr, lane);
    }
    SEAM(7);
    if (IN(8)) {
        PHASE_TID();
        pg8::StaticOrder S; S.init(SEQ, 2048, G, bx);
        {   pg8::Gemm g{AX, WAO, SEQ, 2048, 2048}; pg8::EpiMerge<0> E{GATES, T, Y};
            pg8::gemm_phase<pg8::EpiMerge<0>, pg8::StaticOrder, true, true>(lds, g, S, E, tid); }
        {   pg8::Gemm g{HYTOK, WHO, SEQ, 2048, 1024}; pg8::EpiMerge<1> E{GATES, T, Y};
            pg8::gemm_phase<pg8::EpiMerge<1>, pg8::StaticOrder, true, true>(lds, g, S, E, tid); }
    }
    SEAM(8);
    if (IN(9)) {
        PHASE_TID();
        pg8::Gemm g{Y, WOUT, SEQ, 2048, 2048}; pg8::StaticOrder S; S.init(SEQ, 2048, G, bx);
        pg8::EpiResid E{X1, X1, mods + 5 * DM, mods + 5 * DM, out, 1.0f};
        pg8::gemm_phase<pg8::EpiResid, pg8::StaticOrder, true, true>(lds, g, S, E, tid);
    }
    SEAM(9);
    if (IN(10)) {
        PHASE_TID();
        for (int row = gw; row < SEQ; row += NGW) norm_row_bf16(out + (size_t)row * DM, INP(I_GFFN2), mods + 6 * DM, mods + 7 * DM, HN + (size_t)row * DM, lane);
    }
    SEAM(10);
    if (IN(11)) {
        PHASE_TID();
        pg8::Gemm g{HN, W13B, SEQ, 11264, 2048}; pg8::StaticOrder S; S.init(SEQ, 11264, G, bx);
        pg8::EpiSwiGLU E{ACT, DFF};
        pg8::gemm_phase<pg8::EpiSwiGLU, pg8::StaticOrder, true, true>(lds, g, S, E, tid);
    }
    SEAM(11);
    if (IN(12)) {
        PHASE_TID();
        pg8::Gemm g{ACT, W2B, SEQ, 2048, DFF}; pg8::StaticOrder S; S.init(SEQ, 2048, G, bx);
        pg8::EpiResid E{out, out, mods + 8 * DM, mods + 8 * DM, out, 0.5f};
        pg8::gemm_phase<pg8::EpiResid, pg8::StaticOrder, true, true>(lds, g, S, E, tid);
    }
    SEAM(12);
    if (IN(13)) {
        PHASE_TID();
        for (int row = gw; row < SEQ; row += NGW) final_norm_row(out + (size_t)row * DM, INP(I_GFINAL), lane);
    }
#undef IN
#undef SEAM
#undef PHASE_TID
#undef KP
#undef WSB
#undef INP
#undef mods
#undef rope
#undef qss
#undef kvss
#undef W13A
#undef W2A
#undef WIN
#undef WUQ
#undef WUKV
#undef WAO
#undef WHO
#undef WOUT
#undef W13B
#undef W2B
#undef HN
#undef ACT
#undef X1
#undef HYT
#undef KV
#undef Q
#undef T
#undef HYO
#undef AX
#undef GATES
#undef PQ
#undef PKV
#undef KR
#undef HYTOK
#undef Y
#undef out
#undef hfilt
}


#ifdef DBG_STOP
struct DumpArgs { const void* p[4]; size_t n[4]; int isbf[4]; float* out; size_t nout; };
__global__ void __launch_bounds__(256) dbg_dump(DumpArgs d) {
    for (size_t i = blockIdx.x * 256ull + threadIdx.x; i < d.nout; i += (size_t)gridDim.x * 256ull) {
        float s = 0.f;
        for (int b = 0; b < 4; ++b) { if (!d.p[b]) continue;
            for (size_t j = i; j < d.n[b]; j += d.nout) s += d.isbf[b] ? bf2f(((const unsigned short*)d.p[b])[j]) : ((const float*)d.p[b])[j]; }
        d.out[i] = s;
    }
}
#endif
typedef void (*kern_t)(Args);
template <int K> struct PhaseTab { static void fill(kern_t* t) { t[K] = mk_fwd<K, K + 1>; PhaseTab<K - 1>::fill(t); } };
template <> struct PhaseTab<-1> { static void fill(kern_t*) {} };
extern "C" void kernel_launch(void* const* d_in, const int* in_sizes, int n_in, void* d_out, int out_size, void* d_ws, size_t ws_size, hipStream_t stream) {
    static int grid = 0;
    static kern_t tab[N_PHASES];
    if (grid == 0) {
        if (n_in != 31 || in_sizes[0] != SEQ * DM || out_size != SEQ * DM || ws_size < WS_END) {
            fprintf(stderr, "kernel_launch: unexpected problem: n_in %d in0 %d out %d ws %zu (need %zu); nothing launched\n", n_in, n_in > 0 ? in_sizes[0] : -1, out_size, ws_size, (size_t)WS_END); grid = -1; return; }
        int dev = 0, cus = 0;
        if (hipGetDevice(&dev) != hipSuccess || hipDeviceGetAttribute(&cus, hipDeviceAttributeMultiprocessorCount, dev) != hipSuccess) { grid = -1; return; }
#if MK_N_LAUNCHES == 1
        if (hipFuncSetAttribute((const void*)mk_fwd<0, N_PHASES>, hipFuncAttributeMaxDynamicSharedMemorySize, LDS_BYTES) != hipSuccess) { fprintf(stderr, "kernel_launch: hipFuncSetAttribute failed\n"); grid = -1; return; }
        int per_cu = 0;
        if (hipOccupancyMaxActiveBlocksPerMultiprocessor(&per_cu, (const void*)mk_fwd<0, N_PHASES>, 512, LDS_BYTES) != hipSuccess || per_cu < 1) { fprintf(stderr, "kernel_launch: occupancy query says %d blocks per CU\n", per_cu); }
#else
        PhaseTab<N_PHASES - 1>::fill(tab);
        for (int i = 0; i < N_PHASES; ++i)
            if (hipFuncSetAttribute((const void*)tab[i], hipFuncAttributeMaxDynamicSharedMemorySize, LDS_BYTES) != hipSuccess) { fprintf(stderr, "kernel_launch: hipFuncSetAttribute failed (phase %d)\n", i); grid = -1; return; }
#endif
        (void)hipGetLastError();
        grid = cus;
    }
    if (grid < 0) return;
    (void)hipMemsetAsync((char*)d_ws + WS_CTL, 0, 65536, stream);
    Args a{};
    for (int i = 0; i < 31; ++i) a.in[i] = (const float*)d_in[i];
    a.dst = (float*)d_out; a.ws = (unsigned char*)d_ws;
#if MK_N_LAUNCHES == 1
    void* kargs[] = {&a};
    hipError_t e = hipLaunchCooperativeKernel((const void*)mk_fwd<0, N_PHASES>, dim3(grid), dim3(512), kargs, LDS_BYTES, stream);
    if (e != hipSuccess) fprintf(stderr, "kernel_launch: cooperative launch failed: %s (grid %d)\n", hipGetErrorString(e), grid);
#else
#ifdef DBG_STOP
    for (int li = 0; li <= DBG_STOP; ++li) hipLaunchKernelGGL(tab[li], dim3(grid), dim3(512), LDS_BYTES, stream, a);
    {   DumpArgs d{}; unsigned char* w = (unsigned char*)d_ws; d.out = (float*)d_out; d.nout = (size_t)SEQ * DM;
#if DBG_STOP == 6
        d.p[0] = w + WS_Q; d.n[0] = (size_t)8192 * 3072; d.isbf[0] = 1; d.p[1] = w + WS_KV; d.n[1] = (size_t)MTOT * 4096; d.isbf[1] = 1; d.p[2] = w + WS_HYO; d.n[2] = (size_t)1024 * 8192; d.isbf[2] = 1;
#elif DBG_STOP == 5
        d.p[0] = w + WS_GATES; d.n[0] = (size_t)8192 * 4096; d.isbf[0] = 1; d.p[1] = w + WS_PQ; d.n[1] = (size_t)8192 * 512 + (size_t)MTOT * 512 + (size_t)MTOT * 64; d.isbf[1] = 1; d.p[2] = w + WS_HYT; d.n[2] = (size_t)3072 * 8192; d.isbf[2] = 1; d.p[3] = w + WS_QSS; d.n[3] = (size_t)MTOT * 8; d.isbf[3] = 0;
#elif DBG_STOP == 3
        d.p[0] = w + WS_X1; d.n[0] = (size_t)MTOT * 2048; d.isbf[0] = 0;
#elif DBG_STOP == 2
        d.p[0] = w + WS_ACT; d.n[0] = (size_t)MTOT * DFF; d.isbf[0] = 1;
#elif DBG_STOP == 1
        d.p[0] = w + WS_HN; d.n[0] = (size_t)MTOT * 2048; d.isbf[0] = 1;
#elif DBG_STOP == 0
        d.p[0] = w + WS_W13A; d.n[0] = (WS_HN - WS_W13A) / 2; d.isbf[0] = 1; d.p[1] = w + WS_MODS; d.n[1] = 2 * 18432; d.isbf[1] = 0; d.p[2] = w + WS_ROPE; d.n[2] = 4096; d.isbf[2] = 0;
#elif DBG_STOP == 7
        d.p[0] = w + WS_AX; d.n[0] = (size_t)8192 * 2048; d.isbf[0] = 1; d.p[1] = w + WS_HYTOK; d.n[1] = (size_t)8192 * 1024; d.isbf[1] = 1;
#elif DBG_STOP == 8
        d.p[0] = w + WS_Y; d.n[0] = (size_t)8192 * 2048; d.isbf[0] = 1;
#endif
        hipLaunchKernelGGL(dbg_dump, dim3(2048), dim3(256), 0, stream, d); }
#else
    for (int li = 0; li < N_PHASES; ++li) hipLaunchKernelGGL(tab[li], dim3(grid), dim3(512), LDS_BYTES, stream, a);
#endif
    const hipError_t le = hipPeekAtLastError();
    if (le != hipSuccess) fprintf(stderr, "kernel_launch: launch failed: %s\n", hipGetErrorName(le));
#endif
}
```

```cpp
#include <hip/hip_runtime.h>
#include <hip/hip_cooperative_groups.h>
#include <cstdio>
#include <cstdint>
#include <cmath>

#ifndef MK_N_LAUNCHES
#define MK_N_LAUNCHES 1
#endif
constexpr int N_PHASES = 14;

constexpr int DM = 2048, SEQ = 8192, CTXL = 256, MTOT = SEQ + CTXL, DFF = 5632;
constexpr int HEADS = 16, QLORA = 512, KVLORA = 512, DNOPE = 128, DROPE = 64, DVH = 128, DQH = 192;
constexpr int HYW = 1024, NINP = 8448;
constexpr float NORM_EPS = 1e-6f;

constexpr size_t WS_CTL = 0;
constexpr size_t WS_MODS = 64 * 1024;
constexpr size_t WS_ROPE = 256 * 1024;
constexpr size_t WS_QSS = 320 * 1024;
constexpr size_t WS_KVSS = 640 * 1024;
constexpr size_t WS_W13A = 1u << 20;
constexpr size_t WS_W2A = WS_W13A + (size_t)11264 * 2048 * 2;
constexpr size_t WS_WIN = WS_W2A + (size_t)2048 * 5632 * 2;
constexpr size_t WS_WUQ = WS_WIN + (size_t)NINP * 2048 * 2;
constexpr size_t WS_WUKV = WS_WUQ + (size_t)3072 * 512 * 2;
constexpr size_t WS_WAO = WS_WUKV + (size_t)4096 * 512 * 2;
constexpr size_t WS_WHO = WS_WAO + (size_t)2048 * 2048 * 2;
constexpr size_t WS_WOUT = WS_WHO + (size_t)2048 * 1024 * 2;
constexpr size_t WS_W13B = WS_WOUT + (size_t)2048 * 2048 * 2;
constexpr size_t WS_W2B = WS_W13B + (size_t)11264 * 2048 * 2;
constexpr size_t WS_HN = WS_W2B + (size_t)2048 * 5632 * 2;
constexpr size_t WS_ACT = WS_HN + (size_t)MTOT * 2048 * 2;
constexpr size_t WS_X1 = WS_ACT + (size_t)MTOT * DFF * 2;
constexpr size_t WS_HYT = WS_X1 + (size_t)MTOT * 2048 * 4;
constexpr size_t WS_KV = WS_HYT + (size_t)3072 * 8192 * 2;
constexpr size_t WS_END = WS_KV + (size_t)MTOT * 4096 * 2;
constexpr size_t WS_Q = WS_W13A;
constexpr size_t WS_T = WS_W13A;
constexpr size_t WS_HYO = WS_WIN;
constexpr size_t WS_AX = WS_HN;
constexpr size_t WS_GATES = WS_ACT;
constexpr size_t WS_PQ = WS_GATES + (size_t)8192 * 4096 * 2;
constexpr size_t WS_PKV = WS_PQ + (size_t)8192 * 512 * 2;
constexpr size_t WS_KR = WS_PKV + (size_t)MTOT * 512 * 2;
constexpr size_t WS_HYTOK = WS_HYT;
constexpr size_t WS_Y = WS_KV;
static_assert(WS_KR + (size_t)MTOT * 64 * 2 <= WS_X1, "ACT overlay");
static_assert((size_t)8192 * 3072 * 2 <= WS_WIN - WS_W13A && (size_t)8192 * 2048 * 4 <= WS_WIN - WS_W13A, "Q/T overlay");

constexpr int LDS_BYTES = 163840;
constexpr int LDS_CTL_OFF = LDS_BYTES - 512;

typedef unsigned short bf16;
#define GAS __attribute__((address_space(1)))
#define LAS __attribute__((address_space(3)))
typedef unsigned v4u __attribute__((ext_vector_type(4)));
typedef unsigned v2u __attribute__((ext_vector_type(2)));
typedef float v4f __attribute__((ext_vector_type(4)));
#define LDS_WAIT() asm volatile("s_waitcnt lgkmcnt(0)" ::: "memory")
#define VM_WAIT() asm volatile("s_waitcnt vmcnt(0)" ::: "memory")
__device__ __forceinline__ unsigned f2bf(float f) { unsigned u = __builtin_bit_cast(unsigned, f); return (u + 0x7fffu + ((u >> 16) & 1u)) >> 16; }
__device__ __forceinline__ unsigned pk2(float lo, float hi) { return f2bf(lo) | (f2bf(hi) << 16); }
__device__ __forceinline__ float bf2f(unsigned short b) { return __builtin_bit_cast(float, (unsigned)b << 16); }
__device__ __forceinline__ float fast_sigmoid(float v) { return __builtin_amdgcn_rcpf(1.f + __builtin_amdgcn_exp2f(-1.4426950408889634f * v)); }
__device__ __forceinline__ float wave_sum(float v) {
#pragma unroll
    for (int o = 1; o < 64; o <<= 1) v += __shfl_xor(v, o);
    return v;
}

__device__ __forceinline__ int lane_id_fresh() { int l; asm volatile("v_mbcnt_lo_u32_b32 %0, -1, 0\n\tv_mbcnt_hi_u32_b32 %0, -1, %0" : "=v"(l)); return l; }
namespace pg8 {
#define PG8_LAS __attribute__((address_space(3)))
typedef unsigned short bf16_t;
typedef short bf16x8 __attribute__((ext_vector_type(8)));
typedef float f32x4 __attribute__((ext_vector_type(4)));
typedef unsigned u32x4 __attribute__((ext_vector_type(4)));
constexpr int BM = 256, BK = 64, HALF = 128, HTB = HALF * BK * 2  , STAGE_BYTES = 8 * HTB, NXCD = 8, WGM = 8;

__host__ __device__ __forceinline__ int lds_byte(int r, int c) { const int st = (r >> 4) * 2 + (c >> 5), rr = r & 15, cc = c & 31, ob = rr * 64 + cc * 2; return st * 1024 + (ob ^ (((ob >> 9) & 1) << 5)); }
__host__ __device__ __forceinline__ void stage_rc(int b, int& R, int& C) { const int st = b / 1024, sb = b % 1024, swz = sb ^ (((sb >> 9) & 1) << 5); R = (st >> 1) * 16 + swz / 64; C = (st & 1) * 32 + (swz % 64) / 2; }
__host__ __device__ __forceinline__ int perm32(int rho) { const int n = rho >> 4, i = rho & 15; return 8 * (i >> 2) + 4 * n + (i & 3); }

struct Unit { int pm, pn; int ks = 0; };
struct Gemm { const bf16_t* A; const bf16_t* Bt; int M, N, K; int ld = 0; size_t ksb = 0; };

struct StaticOrder {
    int nM, nN, nwg, G, c;
    __host__ __device__ void init(int M, int N, int G_, int c_) { nM = M / BM; nN = N / BM; nwg = nM * nN; G = G_; c = c_; }
    __host__ __device__ bool next(int i, Unit& u) const {
        const long L = (long)i * G + c; if (L >= nwg) return false;
        int wgid = (int)L; { const int q = nwg / NXCD, r = nwg % NXCD, xcd = wgid % NXCD, off = wgid / NXCD; wgid = (xcd < r ? xcd * (q + 1) : r * (q + 1) + (xcd - r) * q) + off; }
        const int nig = WGM * nN, gid = wgid / nig, fm = gid * WGM, gsz = (nM - fm) < WGM ? (nM - fm) : WGM;
        u.pm = fm + ((wgid % nig) % gsz); u.pn = (wgid % nig) / gsz; return true;
    }
    __device__ __forceinline__ void a_ready(const Unit&) const {}
    __device__ __forceinline__ void done(const Unit&) const {}
};


typedef float f32x2_t __attribute__((ext_vector_type(2))); typedef __bf16 bf16x2_t __attribute__((ext_vector_type(2)));
__device__ __forceinline__ unsigned cvt_pk_bf16(float lo, float hi) { f32x2_t v = {lo, hi}; bf16x2_t b = __builtin_convertvector(v, bf16x2_t); return __builtin_bit_cast(unsigned, b); }
__device__ __forceinline__ u32x4 pack8(const f32x4 v0, const f32x4 v1) { u32x4 w; w.x = cvt_pk_bf16(v0[0], v0[1]); w.y = cvt_pk_bf16(v0[2], v0[3]); w.z = cvt_pk_bf16(v1[0], v1[1]); w.w = cvt_pk_bf16(v1[2], v1[3]); return w; }
__device__ __forceinline__ float sigm(float v) { return __builtin_amdgcn_rcpf(1.f + __builtin_amdgcn_exp2f(-1.4426950408889634f * v)); }

struct EpiSwiGLU {
    static constexpr bool PERM = true, AFTER_DRAIN = false;
    bf16_t* O; int ldc;
    __device__ __forceinline__ void operator()(const f32x4 (&acc)[2][2][4][2], const Unit& u, int wr, int wc, int fr, int fq) const {
        const int row0 = u.pm * BM + wr * 64 + fr, col0 = u.pn * HALF + wc * 32 + 8 * fq;
#pragma unroll
        for (int ai = 0; ai < 2; ++ai)
#pragma unroll
            for (int m = 0; m < 4; ++m) {
                bf16_t* rowp = O + (size_t)(row0 + ai * HALF + m * 16) * ldc + col0;
                f32x4 v[2];
#pragma unroll
                for (int n = 0; n < 2; ++n)
#pragma unroll
                    for (int e = 0; e < 4; ++e) { const float a = acc[ai][0][m][n][e], b = acc[ai][1][m][n][e]; v[n][e] = a * sigm(a) * b; }
                *(u32x4*)rowp = pack8(v[0], v[1]);
            }
    }
};
struct EpiResid {
    static constexpr bool PERM = false, AFTER_DRAIN = false;
    const float* base_x; const float* base_c; const float* gate_x; const float* gate_c; float* out; float coef;
    __device__ __forceinline__ void operator()(const f32x4 (&acc)[2][2][4][2], const Unit& u, int wr, int wc, int fr, int fq) const {
        const bool isc = u.pm >= 32;
        const int row0 = u.pm * BM + wr * 64 + fr, col0 = u.pn * BM + wc * 32 + 4 * fq;
        const float* gate = isc ? gate_c : gate_x;
        f32x4 gv[2][2];
#pragma unroll
        for (int bj = 0; bj < 2; ++bj)
#pragma unroll
            for (int n = 0; n < 2; ++n) gv[bj][n] = *(const f32x4*)(gate + col0 + bj * HALF + n * 16) * coef;
#pragma unroll
        for (int ai = 0; ai < 2; ++ai)
#pragma unroll
            for (int m = 0; m < 4; ++m) {
                const int row = row0 + ai * HALF + m * 16;
                const float* bp = (isc ? base_c + (size_t)(row - 8192) * 2048 : base_x + (size_t)row * 2048) + col0;
                float* op = out + (size_t)row * 2048 + col0;
#pragma unroll
                for (int bj = 0; bj < 2; ++bj)
#pragma unroll
                    for (int n = 0; n < 2; ++n) { const f32x4 b = *(const f32x4*)(bp + bj * HALF + n * 16); *(f32x4*)(op + bj * HALF + n * 16) = b + gv[bj][n] * acc[ai][bj][m][n]; }
            }
    }
};
struct EpiInProj {
    static constexpr bool PERM = true, AFTER_DRAIN = false;
    bf16_t* pq; bf16_t* pkv; bf16_t* kr; bf16_t* hyT; bf16_t* gates; float* qss; float* kvss; const float* rope;
    __device__ __forceinline__ void operator()(const f32x4 (&acc)[2][2][4][2], const Unit& u, int wr, int wc, int fr, int fq) const {
        const int row0 = u.pm * BM + wr * 64 + fr, pn = u.pn;
        if (pn < 4) {
            bf16_t* O = pn < 2 ? pq : pkv; float* ss = pn < 2 ? qss : kvss; const int t = pn & 1;
            const int col0 = t * BM + wc * 32 + 8 * fq;
#pragma unroll
            for (int ai = 0; ai < 2; ++ai)
#pragma unroll
                for (int m = 0; m < 4; ++m) {
                    const int row = row0 + ai * HALF + m * 16; float s = 0.f;
#pragma unroll
                    for (int bj = 0; bj < 2; ++bj) {
                        const f32x4 v0 = acc[ai][bj][m][0], v1 = acc[ai][bj][m][1];
                        s += (v0[0] * v0[0] + v0[1] * v0[1]) + (v0[2] * v0[2] + v0[3] * v0[3]) + (v1[0] * v1[0] + v1[1] * v1[1]) + (v1[2] * v1[2] + v1[3] * v1[3]);
                        *(u32x4*)(O + (size_t)row * 512 + col0 + bj * HALF) = pack8(v0, v1);
                    }
                    s += __shfl_xor(s, 16); s += __shfl_xor(s, 32);
                    if (fq == 0) ss[(size_t)row * 8 + t * 4 + wc] = s;
                }
        } else if (pn < 16) {
            const int ch0 = (pn - 4) * BM + wc * 32 + 8 * fq;
#pragma unroll
            for (int ai = 0; ai < 2; ++ai)
#pragma unroll
                for (int m = 0; m < 4; ++m) {
                    const int row = row0 + ai * HALF + m * 16;
#pragma unroll
                    for (int bj = 0; bj < 2; ++bj)
#pragma unroll
                        for (int n = 0; n < 2; ++n)
#pragma unroll
                            for (int e = 0; e < 4; ++e) hyT[(size_t)(ch0 + bj * HALF + 4 * n + e) * 8192 + row] = (bf16_t)(cvt_pk_bf16(acc[ai][bj][m][n][e], 0.f) & 0xffffu);
                }
        } else if (pn < 32) {
            const int col0 = (pn - 16) * BM + wc * 32 + 8 * fq;
#pragma unroll
            for (int ai = 0; ai < 2; ++ai)
#pragma unroll
                for (int m = 0; m < 4; ++m) {
                    const int row = row0 + ai * HALF + m * 16;
#pragma unroll
                    for (int bj = 0; bj < 2; ++bj) {
                        f32x4 v0 = acc[ai][bj][m][0], v1 = acc[ai][bj][m][1];
#pragma unroll
                        for (int e = 0; e < 4; ++e) { v0[e] = sigm(v0[e]); v1[e] = sigm(v1[e]); }
                        *(u32x4*)(gates + (size_t)row * 4096 + col0 + bj * HALF) = pack8(v0, v1);
                    }
                }
        } else {
            if (wc < 2) {
#pragma unroll
                for (int ai = 0; ai < 2; ++ai)
#pragma unroll
                    for (int m = 0; m < 4; ++m) {
                        const int row = row0 + ai * HALF + m * 16;
                        f32x4 v[2] = {acc[ai][0][m][0], acc[ai][0][m][1]};
                        if (row < 8192) {
                            const int pos = wc == 0 ? (row >> 6) : (row & 63);
#pragma unroll
                            for (int n = 0; n < 2; ++n) {
                                const f32x4 cs = *(const f32x4*)(rope + (size_t)(pos * 16 + 4 * fq + 2 * n) * 2);
                                const float a0 = v[n][0], b0 = v[n][1], a1 = v[n][2], b1 = v[n][3];
                                v[n][0] = a0 * cs[0] - b0 * cs[1]; v[n][1] = a0 * cs[1] + b0 * cs[0];
                                v[n][2] = a1 * cs[2] - b1 * cs[3]; v[n][3] = a1 * cs[3] + b1 * cs[2];
                            }
                        }
                        *(u32x4*)(kr + (size_t)row * 64 + wc * 32 + 8 * fq) = pack8(v[0], v[1]);
                    }
            }
        }
    }
};
struct EpiQUp {
    static constexpr bool PERM = true, AFTER_DRAIN = false;
    bf16_t* Q; const float* qss; const float* rope;
    __device__ __forceinline__ void operator()(const f32x4 (&acc)[2][2][4][2], const Unit& u, int wr, int wc, int fr, int fq) const {
        const int row0 = u.pm * BM + wr * 64 + fr;
#pragma unroll
        for (int ai = 0; ai < 2; ++ai)
#pragma unroll
            for (int m = 0; m < 4; ++m) {
                const int row = row0 + ai * HALF + m * 16;
                const f32x4 s0 = *(const f32x4*)(qss + (size_t)row * 8), s1 = *(const f32x4*)(qss + (size_t)row * 8 + 4);
                const float r = 1.0f / sqrtf(((s0[0] + s0[1]) + (s0[2] + s0[3]) + (s1[0] + s1[1]) + (s1[2] + s1[3])) * (1.0f / 512.0f) + 1e-6f);
#pragma unroll
                for (int bj = 0; bj < 2; ++bj) {
                    const int c32 = u.pn * 8 + bj * 4 + wc, gt = c32 % 6;
                    f32x4 v[2] = {acc[ai][bj][m][0] * r, acc[ai][bj][m][1] * r};
                    if (gt >= 4) {
                        const int pos = gt == 4 ? (row >> 6) : (row & 63);
#pragma unroll
                        for (int n = 0; n < 2; ++n) {
                            const f32x4 cs = *(const f32x4*)(rope + (size_t)(pos * 16 + 4 * fq + 2 * n) * 2);
                            const float a0 = v[n][0], b0 = v[n][1], a1 = v[n][2], b1 = v[n][3];
                            v[n][0] = a0 * cs[0] - b0 * cs[1]; v[n][1] = a0 * cs[1] + b0 * cs[0];
                            v[n][2] = a1 * cs[2] - b1 * cs[3]; v[n][3] = a1 * cs[3] + b1 * cs[2];
                        }
                    }
                    *(u32x4*)(Q + (size_t)row * 3072 + c32 * 32 + 8 * fq) = pack8(v[0], v[1]);
                }
            }
    }
};
struct EpiKVUp {
    static constexpr bool PERM = true, AFTER_DRAIN = false;
    bf16_t* KV; const float* kvss;
    __device__ __forceinline__ void operator()(const f32x4 (&acc)[2][2][4][2], const Unit& u, int wr, int wc, int fr, int fq) const {
        const int row0 = u.pm * BM + wr * 64 + fr, col0 = u.pn * BM + wc * 32 + 8 * fq;
#pragma unroll
        for (int ai = 0; ai < 2; ++ai)
#pragma unroll
            for (int m = 0; m < 4; ++m) {
                const int row = row0 + ai * HALF + m * 16;
                const f32x4 s0 = *(const f32x4*)(kvss + (size_t)row * 8), s1 = *(const f32x4*)(kvss + (size_t)row * 8 + 4);
                const float r = 1.0f / sqrtf(((s0[0] + s0[1]) + (s0[2] + s0[3]) + (s1[0] + s1[1]) + (s1[2] + s1[3])) * (1.0f / 512.0f) + 1e-6f);
#pragma unroll
                for (int bj = 0; bj < 2; ++bj) *(u32x4*)(KV + (size_t)row * 4096 + col0 + bj * HALF) = pack8(acc[ai][bj][m][0] * r, acc[ai][bj][m][1] * r);
            }
    }
};
template <int PASS> struct EpiMerge {
    static constexpr bool PERM = true, AFTER_DRAIN = false;
    const bf16_t* gates; float* T; bf16_t* Y;
    __device__ __forceinline__ void operator()(const f32x4 (&acc)[2][2][4][2], const Unit& u, int wr, int wc, int fr, int fq) const {
        const int row0 = u.pm * BM + wr * 64 + fr, col0 = u.pn * BM + wc * 32 + 8 * fq;
#pragma unroll
        for (int ai = 0; ai < 2; ++ai)
#pragma unroll
            for (int m = 0; m < 4; ++m) {
                const int row = row0 + ai * HALF + m * 16;
#pragma unroll
                for (int bj = 0; bj < 2; ++bj) {
                    const int col = col0 + bj * HALF;
                    const u32x4 g = *(const u32x4*)(gates + (size_t)row * 4096 + PASS * 2048 + col);
                    f32x4 g0, g1;
                    g0[0] = __builtin_bit_cast(float, g.x << 16); g0[1] = __builtin_bit_cast(float, g.x & 0xffff0000u); g0[2] = __builtin_bit_cast(float, g.y << 16); g0[3] = __builtin_bit_cast(float, g.y & 0xffff0000u);
                    g1[0] = __builtin_bit_cast(float, g.z << 16); g1[1] = __builtin_bit_cast(float, g.z & 0xffff0000u); g1[2] = __builtin_bit_cast(float, g.w << 16); g1[3] = __builtin_bit_cast(float, g.w & 0xffff0000u);
                    float* tp = T + (size_t)row * 2048 + col;
                    if (PASS == 0) { *(f32x4*)tp = g0 * acc[ai][bj][m][0]; *(f32x4*)(tp + 4) = g1 * acc[ai][bj][m][1]; }
                    else { const f32x4 t0 = *(const f32x4*)tp, t1 = *(const f32x4*)(tp + 4);
                        *(u32x4*)(Y + (size_t)row * 2048 + col) = pack8(t0 + g0 * acc[ai][bj][m][0], t1 + g1 * acc[ai][bj][m][1]); }
                }
            }
    }
};
struct EpiSlab {
    static constexpr bool PERM = false, AFTER_DRAIN = false;
    float* slab;
    __device__ __forceinline__ void operator()(const f32x4 (&acc)[2][2][4][2], const Unit& u, int wr, int wc, int fr, int fq) const {
        const int row0 = wr * 64 + fr, col0 = u.pn * BM + wc * 32 + 4 * fq;
        float* base = slab + (size_t)u.ks * 256 * 2048;
#pragma unroll
        for (int ai = 0; ai < 2; ++ai)
#pragma unroll
            for (int m = 0; m < 4; ++m) {
                float* op = base + (size_t)(row0 + ai * HALF + m * 16) * 2048 + col0;
#pragma unroll
                for (int bj = 0; bj < 2; ++bj)
#pragma unroll
                    for (int n = 0; n < 2; ++n) *(f32x4*)(op + bj * HALF + n * 16) = acc[ai][bj][m][n];
            }
    }
};
struct SplitKOrder {
    int G, c, nslice, nunits;
    __host__ __device__ void init(int nslice_, int ncol, int G_, int c_) { G = G_; c = c_; nslice = nslice_; nunits = nslice_ * ncol; }
    __host__ __device__ bool next(int i, Unit& u) const { const long L = (long)i * G + c; if (L >= nunits) return false; u.pm = 0; u.pn = (int)L / nslice; u.ks = (int)L % nslice; return true; }
    __device__ __forceinline__ void a_ready(const Unit&) const {}
    __device__ __forceinline__ void done(const Unit&) const {}
};
struct InProjOrder {
    StaticOrder base; int G, c;
    __host__ __device__ void init(int G_, int c_) { base.init(8192, 8448, G_, c_); G = G_; c = c_; }
    __host__ __device__ bool next(int i, Unit& u) const {
        if (base.next(i, u)) return true;
        const long L = (long)i * G + c - base.nwg; if (L < 0 || L >= 3) return false;
        u.pm = 32; u.pn = L == 0 ? 2 : (L == 1 ? 3 : 32); return true;
    }
    __device__ __forceinline__ void a_ready(const Unit&) const {}
    __device__ __forceinline__ void done(const Unit&) const {}
};

template <class Epi, class Sched, bool ALIGN_EPI = false, bool SP2 = false>
__device__ __forceinline__ void gemm_phase(PG8_LAS unsigned char* lds, const Gemm g, const Sched& S, const Epi& E, const int tid) {
    const int wid = __builtin_amdgcn_readfirstlane(tid >> 6), lane = tid & 63, wr = wid >> 2, wc = wid & 3, fr = lane & 15, fq = lane >> 4;
    const int K = g.K, nt = K / BK, ld = g.ld ? g.ld : g.K;
    unsigned voffA[2], voffB[2];
#pragma unroll
    for (int i = 0; i < 2; ++i) { int R, C; stage_rc(tid * 16 + i * 8192, R, C); const int Rb = Epi::PERM ? ((R & ~31) + perm32(R & 31)) : R;
        voffA[i] = (unsigned)(R * ld + C) * 2u; voffB[i] = (unsigned)(Rb * ld + C) * 2u; }
    const size_t kstep = (size_t)(BK * 2);
    const size_t hstep = (size_t)HALF * ld * 2;
    const size_t tstep = 2 * hstep;
    const unsigned ldsw = (unsigned)wid * 1024u;
    const int aoff = lds_byte(wr * 64 + fr, fq * 8), boff = lds_byte(wc * 32 + fr, fq * 8);
#define PG8_SA(b, h) (((b) * 2 + (h)) * HTB)
#define PG8_SB(b, h) ((4 + (b) * 2 + (h)) * HTB)
#define PG8_STAGE(bufoff, gbase, voff) do { _Pragma("unroll") for (int _i = 0; _i < 2; ++_i) \
        __builtin_amdgcn_global_load_lds((const unsigned*)((const char*)(gbase) + (voff)[_i]), (PG8_LAS unsigned*)(lds + (bufoff) + ldsw + _i * 8192), 16, 0, 0); } while (0)
#define PG8_LDA(dst, b, h) do { _Pragma("unroll") for (int m = 0; m < 4; ++m) _Pragma("unroll") for (int k = 0; k < 2; ++k) dst[m][k] = *(const PG8_LAS bf16x8*)(lds + PG8_SA(b, h) + aoff + m * 2048 + k * 1024); } while (0)
#define PG8_LDB(dst, b, h) do { _Pragma("unroll") for (int n = 0; n < 2; ++n) _Pragma("unroll") for (int k = 0; k < 2; ++k) dst[n][k] = *(const PG8_LAS bf16x8*)(lds + PG8_SB(b, h) + boff + n * 2048 + k * 1024); } while (0)
#define PG8_MMA(ai, bj, At, Bt) do { __builtin_amdgcn_s_setprio(1); _Pragma("unroll") for (int m = 0; m < 4; ++m) _Pragma("unroll") for (int n = 0; n < 2; ++n) _Pragma("unroll") for (int k = 0; k < 2; ++k) \
        acc[ai][bj][m][n] = __builtin_amdgcn_mfma_f32_16x16x32_bf16(Bt[n][k], At[m][k], acc[ai][bj][m][n], 0, 0, 0); __builtin_amdgcn_s_setprio(0); } while (0)
#define PG8_WAIT_V(n) asm volatile("s_waitcnt vmcnt(" #n ")" ::: "memory")
#define PG8_WAIT_L(n) asm volatile("s_waitcnt lgkmcnt(" #n ")" ::: "memory")
#define PG8_BAR __builtin_amdgcn_s_barrier()
#define PG8_SCHED __builtin_amdgcn_sched_barrier(0)
    Unit cur, nxt; int ui = 0;
    if (!S.next(0, cur)) return;
    f32x4 acc[2][2][4][2];
#pragma unroll
    for (int a = 0; a < 2; ++a)
#pragma unroll
        for (int b = 0; b < 2; ++b)
#pragma unroll
            for (int m = 0; m < 4; ++m)
#pragma unroll
                for (int n = 0; n < 2; ++n) acc[a][b][m][n] = (f32x4){0.f, 0.f, 0.f, 0.f};
    bf16x8 At[4][2], B0[2][2], B1[2][2];
    const char* cA = (const char*)g.A + (size_t)cur.pm * tstep + (size_t)cur.ks * g.ksb; const char* cB = (const char*)g.Bt + (size_t)cur.pn * tstep + (size_t)cur.ks * g.ksb;
    S.a_ready(cur);
    if constexpr (SP2) {
        PG8_STAGE(PG8_SB(0, 0), cB, voffB); PG8_STAGE(PG8_SB(0, 1), cB + hstep, voffB); PG8_STAGE(PG8_SA(0, 0), cA, voffA); PG8_STAGE(PG8_SA(0, 1), cA + hstep, voffA);
        if (wr == 1) PG8_BAR;
        PG8_WAIT_V(2); PG8_BAR;
        PG8_STAGE(PG8_SB(1, 0), cB + kstep, voffB); PG8_STAGE(PG8_SA(1, 0), cA + kstep, voffA); PG8_STAGE(PG8_SB(1, 1), cB + hstep + kstep, voffB);
        PG8_WAIT_V(6); PG8_BAR;
    } else {
        PG8_STAGE(PG8_SB(0, 0), cB, voffB); PG8_STAGE(PG8_SA(0, 0), cA, voffA); PG8_STAGE(PG8_SB(0, 1), cB + hstep, voffB); PG8_STAGE(PG8_SA(0, 1), cA + hstep, voffA);
        if (wr == 1) PG8_BAR;
        PG8_WAIT_V(4); PG8_BAR;
        PG8_STAGE(PG8_SB(1, 0), cB + kstep, voffB); PG8_STAGE(PG8_SA(1, 0), cA + kstep, voffA); PG8_STAGE(PG8_SB(1, 1), cB + hstep + kstep, voffB);
        PG8_WAIT_V(6); PG8_BAR;
    }
    for (;;) {
        const bool has_next = S.next(ui + 1, nxt);
        const char* nA = has_next ? (const char*)g.A + (size_t)nxt.pm * tstep + (size_t)nxt.ks * g.ksb : cA; const char* nB = has_next ? (const char*)g.Bt + (size_t)nxt.pn * tstep + (size_t)nxt.ks * g.ksb : cB;
        for (int t = 0; t < nt; t += 2) {
            const bool last = (t == nt - 2);
            const char* a1 = cA + (size_t)(t + 1) * kstep;
            const char* a2 = last ? nA : cA + (size_t)(t + 2) * kstep; const char* b2 = last ? nB : cB + (size_t)(t + 2) * kstep;
            const char* a3 = a2 + kstep; const char* b3 = b2 + kstep;
            if (last && has_next) S.a_ready(nxt);
            if constexpr (SP2) {
            PG8_LDB(B0, 0, 0); PG8_LDB(B1, 0, 1); PG8_SCHED; PG8_LDA(At, 0, 0); PG8_STAGE(PG8_SA(1, 1), a1 + hstep, voffA);
            PG8_WAIT_V(8); PG8_WAIT_L(0); PG8_BAR; PG8_MMA(0, 0, At, B0); PG8_MMA(0, 1, At, B1); PG8_BAR; PG8_SCHED;
            PG8_LDA(At, 0, 1); PG8_STAGE(PG8_SB(0, 0), b2, voffB); PG8_STAGE(PG8_SB(0, 1), b2 + hstep, voffB); PG8_STAGE(PG8_SA(0, 0), a2, voffA);
            PG8_WAIT_V(8); PG8_WAIT_L(0); PG8_BAR; PG8_MMA(1, 0, At, B0); PG8_MMA(1, 1, At, B1); PG8_BAR; PG8_SCHED;
            PG8_LDB(B0, 1, 0); PG8_LDB(B1, 1, 1); PG8_SCHED; PG8_LDA(At, 1, 0); PG8_STAGE(PG8_SA(0, 1), a2 + hstep, voffA);
            PG8_WAIT_V(8); PG8_WAIT_L(0); PG8_BAR; PG8_MMA(0, 0, At, B0); PG8_MMA(0, 1, At, B1); PG8_BAR; PG8_SCHED;
            PG8_LDA(At, 1, 1); PG8_STAGE(PG8_SB(1, 0), b3, voffB); PG8_STAGE(PG8_SB(1, 1), b3 + hstep, voffB); PG8_STAGE(PG8_SA(1, 0), a3, voffA);
            PG8_WAIT_V(8); PG8_WAIT_L(0); PG8_BAR; PG8_MMA(1, 0, At, B0); PG8_MMA(1, 1, At, B1); PG8_BAR; PG8_SCHED;
            } else {
            PG8_LDB(B0, 0, 0); PG8_SCHED; PG8_LDA(At, 0, 0); PG8_STAGE(PG8_SA(1, 1), a1 + hstep, voffA);
            PG8_WAIT_L(8); PG8_BAR; PG8_WAIT_L(0); PG8_MMA(0, 0, At, B0); PG8_BAR; PG8_SCHED;
            PG8_LDB(B1, 0, 1); PG8_STAGE(PG8_SB(0, 0), b2, voffB);
            PG8_BAR; PG8_WAIT_L(0); PG8_MMA(0, 1, At, B1); PG8_BAR;
            PG8_LDA(At, 0, 1); PG8_STAGE(PG8_SA(0, 0), a2, voffA);
            PG8_BAR; PG8_WAIT_L(0); PG8_MMA(1, 0, At, B0); PG8_BAR; PG8_SCHED;
            PG8_STAGE(PG8_SB(0, 1), b2 + hstep, voffB);
            PG8_WAIT_V(6); PG8_BAR; PG8_MMA(1, 1, At, B1); PG8_BAR;
            PG8_LDB(B0, 1, 0); PG8_SCHED; PG8_LDA(At, 1, 0); PG8_STAGE(PG8_SA(0, 1), a2 + hstep, voffA);
            PG8_WAIT_L(8); PG8_BAR; PG8_WAIT_L(0); PG8_MMA(0, 0, At, B0); PG8_BAR; PG8_SCHED;
            PG8_LDB(B1, 1, 1); PG8_STAGE(PG8_SB(1, 0), b3, voffB);
            PG8_BAR; PG8_WAIT_L(0); PG8_MMA(0, 1, At, B1); PG8_BAR;
            PG8_LDA(At, 1, 1); PG8_STAGE(PG8_SA(1, 0), a3, voffA);
            PG8_BAR; PG8_WAIT_L(0); PG8_MMA(1, 0, At, B0); PG8_BAR; PG8_SCHED;
            PG8_STAGE(PG8_SB(1, 1), b3 + hstep, voffB);
            PG8_WAIT_V(6); PG8_BAR; PG8_MMA(1, 1, At, B1); PG8_BAR;
            }
        }
        if constexpr (ALIGN_EPI) { if (wr == 0) PG8_BAR; }
        if constexpr (!Epi::AFTER_DRAIN) { E(acc, cur, wr, wc, fr, fq); S.done(cur); }
        if (!has_next) break;
#pragma unroll
        for (int a = 0; a < 2; ++a)
#pragma unroll
            for (int b = 0; b < 2; ++b)
#pragma unroll
                for (int m = 0; m < 4; ++m)
#pragma unroll
                    for (int n = 0; n < 2; ++n) acc[a][b][m][n] = (f32x4){0.f, 0.f, 0.f, 0.f};
        cur = nxt; cA = nA; cB = nB; ++ui;
        if constexpr (ALIGN_EPI) { if (wr == 1) PG8_BAR; }
    }
    PG8_WAIT_V(0);
    if constexpr (!ALIGN_EPI) { if (wr == 0) PG8_BAR; }
    PG8_BAR;
    if constexpr (Epi::AFTER_DRAIN) { E.fused(acc, cur, wr, wc, fr, fq, lds, wid, lane); S.done(cur); }
#undef PG8_SA
#undef PG8_SB
#undef PG8_STAGE
#undef PG8_LDA
#undef PG8_LDB
#undef PG8_MMA
#undef PG8_WAIT_V
#undef PG8_WAIT_L
#undef PG8_BAR
#undef PG8_SCHED
}
}

namespace att {
using bf16x8 = __attribute__((ext_vector_type(8))) short;
using s16x4  = __attribute__((ext_vector_type(4))) short;
using f32x16 = __attribute__((ext_vector_type(16))) float;
using u32x4  = __attribute__((ext_vector_type(4))) unsigned;
constexpr int NW = 8, QBLK = 32, KVBLK = 64;
#ifndef ATT_NQREG
#define ATT_NQREG 3
#endif
#ifndef QKT_PIN
#define QKT_PIN 1
#endif
#ifndef QKT_PIN_MASK
#define QKT_PIN_MASK 3
#endif
constexpr int NQREG = ATT_NQREG, NQLDS = 12 - NQREG;
constexpr float SCALE = 0.07216878364870322f;
constexpr float THR = 8.f;
constexpr int LDQ = 3072, LDK = 4096, LDR = 64, LDO = 2048;
constexpr int SHM_V = KVBLK * 128 * 2, SHM_K = KVBLK * 128 * 2, SHM_R = KVBLK * 64 * 2;
constexpr int OFF_V = 0, OFF_K = 2 * SHM_V, OFF_R = OFF_K + 2 * SHM_K, OFF_WS = OFF_R + 2 * SHM_R, OFF_QR = OFF_WS + NW * 64 * 4, SHM_ATTN = OFF_QR + NW * NQLDS * 1024;
#define KSWZ(row, colB) ((row) * 256 + ((colB) ^ (((row) & 7) << 4)))
#define RSWZ(row, ch) ((row) * 128 + ((((ch) ^ (((row) >> 1) & 7))) << 4))
#define SBAR() __builtin_amdgcn_sched_barrier(0)
__device__ __forceinline__ int crow(int r, int hi) { return (r & 3) + 8 * (r >> 2) + 4 * hi; }
typedef float f32x2_t __attribute__((ext_vector_type(2))); typedef __bf16 bf16x2_t __attribute__((ext_vector_type(2)));
__device__ __forceinline__ unsigned cvtpk(float lo, float hi) { f32x2_t v = {lo, hi}; bf16x2_t b = __builtin_convertvector(v, bf16x2_t); return __builtin_bit_cast(unsigned, b); }

__device__ __forceinline__ void partialSM(f32x16& p0, f32x16& p1, float& m_reg, float& mn, float& alpha) {
  constexpr float C = SCALE * 1.4426950408889634f;
  float pmax = p0[0];
#pragma unroll
  for (int r = 1; r < 16; ++r) pmax = fmaxf(pmax, p0[r]);
#pragma unroll
  for (int r = 0; r < 16; ++r) pmax = fmaxf(pmax, p1[r]);
  { auto rr = __builtin_amdgcn_permlane32_swap(__float_as_uint(pmax), __float_as_uint(pmax), false, false);
    pmax = fmaxf(__uint_as_float(rr[0]), __uint_as_float(rr[1])); }
  if (__builtin_expect(__all(pmax - m_reg <= THR / SCALE), 1)) { mn = m_reg; alpha = 1.f; }
  else { mn = fmaxf(m_reg, pmax); alpha = __builtin_amdgcn_exp2f((m_reg - mn) * C); m_reg = mn; }
  float mnC = -mn * C;
#pragma unroll
  for (int r = 0; r < 16; ++r) p0[r] = fmaf(p0[r], C, mnC);
#pragma unroll
  for (int r = 0; r < 16; ++r) p1[r] = fmaf(p1[r], C, mnC);
#pragma unroll
  for (int r = 0; r < 16; ++r) p0[r] = __builtin_amdgcn_exp2f(p0[r]);
}
__device__ __forceinline__ void finishSM(f32x16& p0, f32x16& p1, float alpha, float& l_reg, bf16x8& pa0, bf16x8& pa1, bf16x8& pa2, bf16x8& pa3) {
#pragma unroll
  for (int r = 0; r < 16; ++r) p1[r] = __builtin_amdgcn_exp2f(p1[r]);
  float ps = 0;
#pragma unroll
  for (int r = 0; r < 16; ++r) ps += p0[r];
#pragma unroll
  for (int r = 0; r < 16; ++r) ps += p1[r];
  { auto rr = __builtin_amdgcn_permlane32_swap(__float_as_uint(ps), __float_as_uint(ps), false, false);
    ps = __uint_as_float(rr[0]) + __uint_as_float(rr[1]); }
  l_reg = l_reg * alpha + ps;
#define PK4(P, BASE, OUT) do { unsigned a0 = cvtpk(P[BASE + 0], P[BASE + 1]), a1 = cvtpk(P[BASE + 2], P[BASE + 3]);   \
    unsigned b0 = cvtpk(P[BASE + 4], P[BASE + 5]), b1 = cvtpk(P[BASE + 6], P[BASE + 7]);                              \
    auto r0 = __builtin_amdgcn_permlane32_swap(a0, b0, false, false); auto r1 = __builtin_amdgcn_permlane32_swap(a1, b1, false, false); \
    u32x4 w = {r0[0], r1[0], r0[1], r1[1]}; OUT = *reinterpret_cast<bf16x8*>(&w); } while (0)
  PK4(p0, 0, pa0); PK4(p0, 8, pa1); PK4(p1, 0, pa2); PK4(p1, 8, pa3);
#undef PK4
}
typedef LAS char* lp_t; typedef const LAS char* clp_t;
__device__ __forceinline__ void qkt(f32x16& p0, f32x16& p1, clp_t Ks, clp_t Rs, const bf16x8* qr, clp_t Qr, int r32, int hi) {
  p0 = f32x16{}; p1 = f32x16{};
#pragma unroll
  for (int d0 = 0; d0 < 8; ++d0) { int cb = (d0 * 16 + hi * 8) * 2;
    bf16x8 b0 = *(const LAS bf16x8*)(Ks + KSWZ(r32, cb));
    bf16x8 b1 = *(const LAS bf16x8*)(Ks + KSWZ(32 + r32, cb));
    bf16x8 qv; if (d0 < NQREG) qv = qr[d0]; else qv = *(const LAS bf16x8*)(Qr + (d0 - NQREG) * 1024);
    p0 = __builtin_amdgcn_mfma_f32_32x32x16_bf16(b0, qv, p0, 0, 0, 0);
    p1 = __builtin_amdgcn_mfma_f32_32x32x16_bf16(b1, qv, p1, 0, 0, 0);
    if (QKT_PIN && (d0 & (QKT_PIN_MASK)) == (QKT_PIN_MASK)) SBAR(); }
#pragma unroll
  for (int d0 = 0; d0 < 4; ++d0) { int ch = d0 * 2 + hi;
    bf16x8 b0 = *(const LAS bf16x8*)(Rs + RSWZ(r32, ch));
    bf16x8 b1 = *(const LAS bf16x8*)(Rs + RSWZ(32 + r32, ch));
    bf16x8 qv; if (8 + d0 < NQREG) qv = qr[8 + d0]; else qv = *(const LAS bf16x8*)(Qr + (8 + d0 - NQREG) * 1024);
    p0 = __builtin_amdgcn_mfma_f32_32x32x16_bf16(b0, qv, p0, 0, 0, 0);
    p1 = __builtin_amdgcn_mfma_f32_32x32x16_bf16(b1, qv, p1, 0, 0, 0); }
}
__device__ __forceinline__ int v_st(int k, int c) { const int kk = (k & ~0xC) | ((k & 4) << 1) | ((k & 8) >> 1); return ((kk >> 3) * 4 + (c >> 5)) * 512 + ((kk & 7) * 32 + (c & 31)) * 2; }
__device__ __forceinline__ int v_rd_base(int lane) { return ((lane & 3) << 3) | (((lane >> 2) & 3) << 6) | (((lane >> 4) & 1) << 5) | (((lane >> 5) & 1) << 8); }
constexpr int v_rd_off(int d0, int ks, int half) { return d0 * 512 + ks * 4096 + half * 2048; }
template <int OFF> __device__ __forceinline__ s16x4 tr_read(int vb) {
  s16x4 r; asm volatile("ds_read_b64_tr_b16 %0, %1 offset:%2" : "=&v"(r) : "v"(vb), "i"(OFF) : "memory"); return r;
}
template <int D0> __device__ __forceinline__ void pv_one(f32x16& od, int vb, bf16x8 pa0, bf16x8 pa1, bf16x8 pa2, bf16x8 pa3) {
  const s16x4 l0 = tr_read<v_rd_off(D0, 0, 0)>(vb), h0 = tr_read<v_rd_off(D0, 0, 1)>(vb), l1 = tr_read<v_rd_off(D0, 1, 0)>(vb), h1 = tr_read<v_rd_off(D0, 1, 1)>(vb);
  const s16x4 l2 = tr_read<v_rd_off(D0, 2, 0)>(vb), h2 = tr_read<v_rd_off(D0, 2, 1)>(vb), l3 = tr_read<v_rd_off(D0, 3, 0)>(vb), h3 = tr_read<v_rd_off(D0, 3, 1)>(vb);
  asm volatile("s_waitcnt lgkmcnt(0)" ::: "memory"); SBAR();
#define PK(L, H) (bf16x8){L[0], L[1], L[2], L[3], H[0], H[1], H[2], H[3]}
  od = __builtin_amdgcn_mfma_f32_32x32x16_bf16(pa0, PK(l0, h0), od, 0, 0, 0);
  od = __builtin_amdgcn_mfma_f32_32x32x16_bf16(pa1, PK(l1, h1), od, 0, 0, 0);
  od = __builtin_amdgcn_mfma_f32_32x32x16_bf16(pa2, PK(l2, h2), od, 0, 0, 0);
  od = __builtin_amdgcn_mfma_f32_32x32x16_bf16(pa3, PK(l3, h3), od, 0, 0, 0);
#undef PK
}
__device__ __forceinline__ void pv_d0(f32x16* o, int vb, bf16x8 pa0, bf16x8 pa1, bf16x8 pa2, bf16x8 pa3) {
  pv_one<0>(o[0], vb, pa0, pa1, pa2, pa3); pv_one<1>(o[1], vb, pa0, pa1, pa2, pa3); pv_one<2>(o[2], vb, pa0, pa1, pa2, pa3); pv_one<3>(o[3], vb, pa0, pa1, pa2, pa3);
}
__device__ __forceinline__ void attn_unit(const unsigned short* __restrict__ Qb, const unsigned short* __restrict__ Kbase0, const unsigned short* __restrict__ Kn,
                                          const unsigned short* __restrict__ Kr, unsigned short* __restrict__ Ob, int seq, LAS char* lds, const int tid) {
  const int wid = __builtin_amdgcn_readfirstlane(tid >> 6), lane = tid & 63, r32 = lane & 31, hi = lane >> 5;
  lp_t V_lds = lds + OFF_V; lp_t K_lds = lds + OFF_K; lp_t R_lds = lds + OFF_R;
  LAS float* ws = (LAS float*)(lds + OFF_WS) + wid * 64; LAS float* li_l = ws; LAS float* al_l = ws + 32;
  float m_reg = -1e30f, l_reg = 0; f32x16 o[4] = {}; bf16x8 qr[NQREG > 0 ? NQREG : 1];
  const unsigned short* Qw = Qb + (long)(wid * QBLK + r32) * LDQ + hi * 8;
#pragma unroll
  for (int d0 = 0; d0 < NQREG; ++d0) qr[d0] = *reinterpret_cast<const bf16x8*>(Qw + d0 * 16);
  lp_t Qr = lds + OFF_QR + wid * (NQLDS * 1024) + (hi * 32 + r32) * 16;
#pragma unroll
  for (int d0 = NQREG; d0 < 12; ++d0) *(LAS bf16x8*)(Qr + (d0 - NQREG) * 1024) = *reinterpret_cast<const bf16x8*>(Qw + d0 * 16);
  const int sr = tid >> 4, sc = (tid & 15) * 8, vst0 = v_st(sr, sc), vst1 = v_st(32 + sr, sc);
  const int rk = tid >> 3, rch = tid & 7, rst = RSWZ(rk, rch);
  const int vb0 = (int)(unsigned)(uintptr_t)V_lds + v_rd_base(lane);
  bf16x8 vs0, vs1, ks0, ks1, rs0;
  const __amdgpu_buffer_rsrc_t srdKV = __builtin_amdgcn_make_buffer_rsrc((void*)Kn, (short)0, (int)(((long)seq * LDK - (Kn - Kbase0)) * 2), 0x00020000);
  const __amdgpu_buffer_rsrc_t srdR = __builtin_amdgcn_make_buffer_rsrc((void*)Kr, (short)0, (int)((long)seq * LDR * 2), 0x00020000);
  const int voffKV = (sr * LDK + sc) * 2, voffR = (rk * LDR + rch * 8) * 2;
#define BLD(srd, vo, so) __builtin_bit_cast(bf16x8, __builtin_amdgcn_raw_buffer_load_b128(srd, vo, so, 0))
#define SLOAD(k0) do { const int so_ = __builtin_amdgcn_readfirstlane((k0) * LDK * 2); \
    vs0 = BLD(srdKV, voffKV + 256, so_); vs1 = BLD(srdKV, voffKV + 256, so_ + 32 * LDK * 2); \
    ks0 = BLD(srdKV, voffKV, so_); ks1 = BLD(srdKV, voffKV, so_ + 32 * LDK * 2); \
    rs0 = BLD(srdR, voffR, __builtin_amdgcn_readfirstlane((k0) * LDR * 2)); } while (0)
#define SWRITE(b) do { *(LAS bf16x8*)(V_lds + (b) * SHM_V + vst0) = vs0; *(LAS bf16x8*)(V_lds + (b) * SHM_V + vst1) = vs1; int kc = sc * 2; \
    *(LAS bf16x8*)(K_lds + (b) * SHM_K + KSWZ(sr, kc)) = ks0; *(LAS bf16x8*)(K_lds + (b) * SHM_K + KSWZ(32 + sr, kc)) = ks1; \
    *(LAS bf16x8*)(R_lds + (b) * SHM_R + rst) = rs0; } while (0)
#define SWAIT() asm volatile("s_waitcnt vmcnt(0)" ::: "memory")
#define RESC(a) do { if (__any((a) < 1.f)) { if (hi == 0) al_l[r32] = (a); asm volatile("s_waitcnt lgkmcnt(0)" ::: "memory"); \
    _Pragma("unroll") for (int d = 0; d < 4; ++d) _Pragma("unroll") for (int r = 0; r < 16; ++r) o[d][r] *= al_l[crow(r, hi)]; } } while (0)
  f32x16 pA0, pA1, pB0, pB1; float mnA, mnB, alA, alB; bf16x8 pa0, pa1, pa2, pa3; const int NT = seq / KVBLK;
  SLOAD(0); SWAIT(); SWRITE(0); __syncthreads();
  qkt(pA0, pA1, K_lds, R_lds, qr, Qr, r32, hi); partialSM(pA0, pA1, m_reg, mnA, alA);
  SLOAD(KVBLK);
  SWAIT(); SWRITE(1); __syncthreads();
  for (int j = 1; j + 1 < NT; j += 2) {
    SBAR(); qkt(pB0, pB1, K_lds + SHM_K, R_lds + SHM_R, qr, Qr, r32, hi);
    finishSM(pA0, pA1, alA, l_reg, pa0, pa1, pa2, pa3); SBAR();
    SLOAD((j + 1) * KVBLK); SBAR();
    pv_d0(o, vb0, pa0, pa1, pa2, pa3); partialSM(pB0, pB1, m_reg, mnB, alB);
    __syncthreads(); SWAIT(); SWRITE(0);
    RESC(alB); __syncthreads();
    SBAR(); qkt(pA0, pA1, K_lds, R_lds, qr, Qr, r32, hi);
    finishSM(pB0, pB1, alB, l_reg, pa0, pa1, pa2, pa3); SBAR();
    SLOAD((j + 2) * KVBLK); SBAR();
    pv_d0(o, vb0 + SHM_V, pa0, pa1, pa2, pa3); partialSM(pA0, pA1, m_reg, mnA, alA);
    __syncthreads(); SWAIT(); SWRITE(1);
    RESC(alA); __syncthreads();
  }
  SBAR(); qkt(pB0, pB1, K_lds + SHM_K, R_lds + SHM_R, qr, Qr, r32, hi);
  finishSM(pA0, pA1, alA, l_reg, pa0, pa1, pa2, pa3); SBAR();
  pv_d0(o, vb0, pa0, pa1, pa2, pa3); partialSM(pB0, pB1, m_reg, mnB, alB);
  __syncthreads(); RESC(alB);
  finishSM(pB0, pB1, alB, l_reg, pa0, pa1, pa2, pa3); SBAR();
  pv_d0(o, vb0 + SHM_V, pa0, pa1, pa2, pa3);
  if (hi == 0) li_l[r32] = l_reg; asm volatile("s_waitcnt lgkmcnt(0)" ::: "memory");
  float rli[16];
#pragma unroll
  for (int r = 0; r < 16; ++r) rli[r] = __builtin_amdgcn_rcpf(li_l[crow(r, hi)]);
  unsigned short* Ow = Ob + (long)(wid * QBLK) * LDO;
#pragma unroll
  for (int r = 0; r < 16; ++r) { int orow = crow(r, hi);
#pragma unroll
    for (int d0 = 0; d0 < 4; ++d0) Ow[(long)orow * LDO + d0 * 32 + r32] = (unsigned short)(cvtpk(o[d0][r] * rli[r], 0.f) & 0xffffu); }
  __syncthreads();
#undef SLOAD
#undef BLD
#undef SWRITE
#undef SWAIT
#undef RESC
}
#undef KSWZ
#undef RSWZ
#undef SBAR
}

#define HD __device__ __forceinline__
#if defined(__HIPCC__)
typedef float cplx __attribute__((ext_vector_type(2)));
HD cplx mkc(float a, float b) { cplx r; r.x = a; r.y = b; return r; }
#endif
constexpr int FFT_M = 8192;
constexpr int FFT_BUF = 8704;
HD int fpad(int i) { return i + 2 * (i >> 5); }
HD int rev13(unsigned k) {
#if defined(__HIP_DEVICE_COMPILE__)
    return (int)(__brev(k) >> 19);
#else
    unsigned r = 0; for (int b = 0; b < 13; ++b) r |= ((k >> b) & 1u) << (12 - b); return (int)r;
#endif
}
HD void cs_rev(float rev, float& c, float& s) {
#if defined(__HIP_DEVICE_COMPILE__)
    c = __builtin_amdgcn_cosf(rev); s = __builtin_amdgcn_sinf(rev);
#else
    c = (float)cos(6.283185307179586 * (double)rev); s = (float)sin(6.283185307179586 * (double)rev);
#endif
}
HD cplx cmulf(cplx a, cplx b) { return mkc(a.x * b.x - a.y * b.y, a.x * b.y + a.y * b.x); }

template <int SHIFT, int S0, bool INV, typename BufT>
HD void fft_pass16(int tid, BufT buf) {
#if defined(__HIP_DEVICE_COMPILE__)
    asm volatile("" : "+v"(tid));
#endif
    const int lo = tid & ((1 << SHIFT) - 1);
    const int base = ((tid >> SHIFT) << (SHIFT + 4)) | lo;
    cplx r[16];
#pragma unroll
    for (int j = 0; j < 16; ++j) r[j] = buf[fpad(base + (j << SHIFT))];
    if (!INV) {
#pragma unroll
        for (int ss = 0; ss < 4; ++ss) {
            const int hj = 8 >> ss;
#pragma unroll
            for (int j = 0; j < 16; ++j) {
                if (j & hj) continue;
                const int e = (lo + ((j & (hj - 1)) << SHIFT)) << (S0 + ss);
                float c, s; cs_rev((float)e * (1.0f / FFT_M), c, s);
                const cplx a = r[j], b = r[j + hj];
                r[j] = mkc(a.x + b.x, a.y + b.y);
                const cplx d = mkc(a.x - b.x, a.y - b.y);
                r[j + hj] = cmulf(d, mkc(c, -s));
            }
        }
    } else {
#pragma unroll
        for (int ss = 3; ss >= 0; --ss) {
            const int hj = 8 >> ss;
#pragma unroll
            for (int j = 0; j < 16; ++j) {
                if (j & hj) continue;
                const int e = (lo + ((j & (hj - 1)) << SHIFT)) << (S0 + ss);
                float c, s; cs_rev((float)e * (1.0f / FFT_M), c, s);
                const cplx t = cmulf(r[j + hj], mkc(c, s));
                const cplx a = r[j];
                r[j] = mkc(a.x + t.x, a.y + t.y);
                r[j + hj] = mkc(a.x - t.x, a.y - t.y);
            }
        }
    }
#pragma unroll
    for (int j = 0; j < 16; ++j) buf[fpad(base + (j << SHIFT))] = r[j];
}
template <typename BufT>
HD void fft_pass_last(int tid, BufT buf) {
#pragma unroll
    for (int q = 0; q < 8; ++q) {
        const int i = 2 * (tid + 512 * q), p = fpad(i);
        const cplx a = buf[p], b = buf[p + 1];
        buf[p] = mkc(a.x + b.x, a.y + b.y);
        buf[p + 1] = mkc(a.x - b.x, a.y - b.y);
    }
}
template <typename BufT>
HD void fft_combine(int tid, BufT A, BufT B) {
#if defined(__HIP_DEVICE_COMPILE__)
    asm volatile("" : "+v"(tid));
#endif
#pragma unroll 1
    for (int q = 0; q < 9; ++q) {
        const int k = tid + 512 * q;
        if (k > FFT_M / 2) break;
        const int pk = fpad(rev13((unsigned)k)), pm = fpad(rev13((unsigned)((FFT_M - k) & (FFT_M - 1))));
        const cplx za = A[pk], zb = A[pm], ha = B[pk], hb = B[pm];
        float c, s; cs_rev((float)k * (1.0f / (2 * FFT_M)), c, s);
        const cplx w = mkc(c, -s);
        const cplx Ex = mkc(0.5f * (za.x + zb.x), 0.5f * (za.y - zb.y));
        const cplx Dx = mkc(za.x - zb.x, za.y + zb.y);
        const cplx Ox = mkc(0.5f * Dx.y, -0.5f * Dx.x);
        const cplx Eh = mkc(0.5f * (ha.x + hb.x), 0.5f * (ha.y - hb.y));
        const cplx Dh = mkc(ha.x - hb.x, ha.y + hb.y);
        const cplx Oh = mkc(0.5f * Dh.y, -0.5f * Dh.x);
        const cplx wOx = cmulf(w, Ox), wOh = cmulf(w, Oh);
        const cplx X1 = mkc(Ex.x + wOx.x, Ex.y + wOx.y), X2 = mkc(Ex.x - wOx.x, Ex.y - wOx.y);
        const cplx H1 = mkc(Eh.x + wOh.x, Eh.y + wOh.y), H2 = mkc(Eh.x - wOh.x, Eh.y - wOh.y);
        const cplx Y1 = cmulf(X1, H1), Y2 = cmulf(X2, H2);
        const cplx Ey = mkc(0.5f * (Y1.x + Y2.x), 0.5f * (Y1.y + Y2.y));
        const cplx Dy = mkc(0.5f * (Y1.x - Y2.x), 0.5f * (Y1.y - Y2.y));
        const cplx Oy = cmulf(Dy, mkc(c, s));
        A[pk] = mkc(Ey.x - Oy.y, Ey.y + Oy.x);
        if (k != 0 && k != FFT_M / 2) A[pm] = mkc(Ey.x + Oy.y, -Ey.y + Oy.x);
    }
}
template <typename BufT>
HD void fft_put16(int tid, BufT buf, const float* x16) {
#pragma unroll
    for (int q = 0; q < 8; ++q) {
        buf[fpad(8 * tid + q)] = mkc(x16[2 * q], x16[2 * q + 1]);
        buf[fpad(4096 + 8 * tid + q)] = mkc(0.f, 0.f);
    }
}
template <typename BufT>
HD void fft_get16_mid(int tid, BufT buf, float* y16) {
#pragma unroll
    for (int q = 0; q < 8; ++q) { const cplx f = buf[fpad(2048 + 8 * tid + q)]; y16[2 * q] = f.x; y16[2 * q + 1] = f.y; }
}

typedef LAS cplx* lbuf_t;
__device__ __forceinline__ void fft_fwd2(int tid, lbuf_t A, lbuf_t B) {
    __syncthreads();
    fft_pass16<9, 0, false>(tid, A); __builtin_amdgcn_sched_barrier(0); fft_pass16<9, 0, false>(tid, B); __syncthreads();
    fft_pass16<5, 4, false>(tid, A); __builtin_amdgcn_sched_barrier(0); fft_pass16<5, 4, false>(tid, B); __syncthreads();
    fft_pass16<1, 8, false>(tid, A); __builtin_amdgcn_sched_barrier(0); fft_pass16<1, 8, false>(tid, B); __syncthreads();
    fft_pass_last(tid, A); fft_pass_last(tid, B); __syncthreads();
}
__device__ __forceinline__ void fft_inv1(int tid, lbuf_t A) {
    fft_pass_last(tid, A); __syncthreads();
    fft_pass16<1, 8, true>(tid, A); __syncthreads();
    fft_pass16<5, 4, true>(tid, A); __syncthreads();
    fft_pass16<9, 0, true>(tid, A); __syncthreads();
}
__device__ __forceinline__ void shortconv16(const bf16* hyT, int ch, int tid, const float* conv_w, const float* conv_b, float* out) {
    const bf16* p = hyT + (size_t)ch * 8192 + 16 * tid;
    const v4u a = *(const v4u*)p, b = *(const v4u*)(p + 8);
    float u[18];
    u[0] = tid > 0 ? bf2f(p[-1]) : 0.f; u[17] = tid < 511 ? bf2f(p[16]) : 0.f;
    const unsigned w[8] = {a.x, a.y, a.z, a.w, b.x, b.y, b.z, b.w};
#pragma unroll
    for (int i = 0; i < 8; ++i) { u[1 + 2 * i] = __builtin_bit_cast(float, w[i] << 16); u[2 + 2 * i] = __builtin_bit_cast(float, w[i] & 0xffff0000u); }
    const float w0 = conv_w[ch], w1 = conv_w[3072 + ch], w2 = conv_w[6144 + ch], bb = conv_b[ch];
#pragma unroll
    for (int i = 0; i < 16; ++i) out[i] = w0 * u[i] + w1 * u[i + 1] + w2 * u[i + 2] + bb;
}
__device__ __forceinline__ float block_sum512(float v, LAS float* red, int tid) {
    v = wave_sum(v);
    if ((tid & 63) == 0) red[tid >> 6] = v;
    __syncthreads();
    float s = 0.f;
#pragma unroll
    for (int i = 0; i < 8; ++i) s += red[i];
    __syncthreads();
    return s;
}
__device__ __forceinline__ void hyena_unit(int c, const bf16* hyT, const float* conv_w, const float* conv_b, const float* hfilt, const float* skip, bf16* hyo, LAS unsigned char* lds, const int tid) {
    lbuf_t A = (lbuf_t)lds, B = (lbuf_t)(lds + FFT_BUF * 8);
    LAS float* red = (LAS float*)(lds + 2 * FFT_BUF * 8);
    float v[16], y[16], g[16];
    float ss = 0.f;
    { const float* hp = hfilt + (size_t)c * 8192 + 16 * tid;
#pragma unroll
      for (int i = 0; i < 4; ++i) { const v4f h4 = *(const v4f*)(hp + 4 * i); g[4 * i] = h4[0]; g[4 * i + 1] = h4[1]; g[4 * i + 2] = h4[2]; g[4 * i + 3] = h4[3]; }
#pragma unroll
      for (int i = 0; i < 16; ++i) ss += g[i] * g[i]; }
    fft_put16(tid, B, g);
    shortconv16(hyT, c, tid, conv_w, conv_b, v);
    fft_put16(tid, A, v);
    const float rn0 = (1.0f / sqrtf(block_sum512(ss, red, tid) + 1e-6f)) * (1.0f / FFT_M);
    fft_fwd2(tid, A, B);
    fft_combine(tid, A, B); __syncthreads();
    fft_inv1(tid, A);
    fft_get16_mid(tid, A, y);
    shortconv16(hyT, 1024 + c, tid, conv_w, conv_b, g);
    const float sk0 = skip[c], sk1 = skip[1024 + c];
#pragma unroll
    for (int i = 0; i < 16; ++i) v[i] = g[i] * (y[i] * rn0 + sk0 * v[i]);
    __syncthreads();
    ss = 0.f;
    { const float* hp = hfilt + (size_t)(1024 + c) * 8192 + 16 * tid;
#pragma unroll
      for (int i = 0; i < 4; ++i) { const v4f h4 = *(const v4f*)(hp + 4 * i); g[4 * i] = h4[0]; g[4 * i + 1] = h4[1]; g[4 * i + 2] = h4[2]; g[4 * i + 3] = h4[3]; }
#pragma unroll
      for (int i = 0; i < 16; ++i) ss += g[i] * g[i]; }
    fft_put16(tid, B, g);
    fft_put16(tid, A, v);
    const float rn1 = (1.0f / sqrtf(block_sum512(ss, red, tid) + 1e-6f)) * (1.0f / FFT_M);
    fft_fwd2(tid, A, B);
    fft_combine(tid, A, B); __syncthreads();
    fft_inv1(tid, A);
    fft_get16_mid(tid, A, y);
    shortconv16(hyT, 2048 + c, tid, conv_w, conv_b, g);
    v4u o0, o1;
    float r[16];
#pragma unroll
    for (int i = 0; i < 16; ++i) r[i] = g[i] * (y[i] * rn1 + sk1 * v[i]);
    o0.x = pk2(r[0], r[1]); o0.y = pk2(r[2], r[3]); o0.z = pk2(r[4], r[5]); o0.w = pk2(r[6], r[7]);
    o1.x = pk2(r[8], r[9]); o1.y = pk2(r[10], r[11]); o1.z = pk2(r[12], r[13]); o1.w = pk2(r[14], r[15]);
    bf16* op = hyo + (size_t)c * 8192 + 16 * tid;
    *(v4u*)op = o0; *(v4u*)(op + 8) = o1;
    __syncthreads();
}

template <class ColFn>
__device__ __forceinline__ void cvt_item(const float* W, int K, int N, bf16* WT, int nblk, ColFn col, const float* kscale, LAS float* scr, int item, int lane) {
    const int kb = item / nblk, nb = item % nblk, k0 = 64 * kb, n0 = 64 * nb;
    const int nl = 4 * (lane & 15), kq = lane >> 4;
    const int s0 = col(n0 + nl), s1 = col(n0 + nl + 1), s2 = col(n0 + nl + 2), s3 = col(n0 + nl + 3);
    const bool vec = s0 >= 0 && (s0 & 3) == 0 && s1 == s0 + 1 && s2 == s0 + 2 && s3 == s0 + 3;
    v4f val[16];
    if (__all(vec)) {
#pragma unroll
        for (int i = 0; i < 16; ++i) val[i] = *(const v4f*)(W + (size_t)(k0 + 4 * i + kq) * N + s0);
    } else {
#pragma unroll
        for (int i = 0; i < 16; ++i) { const float* r = W + (size_t)(k0 + 4 * i + kq) * N;
            val[i][0] = s0 >= 0 ? r[s0] : 0.f; val[i][1] = s1 >= 0 ? r[s1] : 0.f; val[i][2] = s2 >= 0 ? r[s2] : 0.f; val[i][3] = s3 >= 0 ? r[s3] : 0.f; }
    }
#pragma unroll
    for (int i = 0; i < 16; ++i) { const int kk = 4 * i + kq; v4f x = val[i]; if (kscale) x = x * kscale[k0 + kk];
        LAS float* p = scr + kk * 65 + nl; p[0] = x[0]; p[1] = x[1]; p[2] = x[2]; p[3] = x[3]; }
    LDS_WAIT(); asm volatile("" ::: "memory");
    const int c = lane & 7;
#pragma unroll
    for (int j = 0; j < 8; ++j) { const int n = (lane >> 3) + 8 * j; const LAS float* s = scr + (8 * c) * 65 + n;
        v4u o; o.x = pk2(s[0 * 65], s[1 * 65]); o.y = pk2(s[2 * 65], s[3 * 65]); o.z = pk2(s[4 * 65], s[5 * 65]); o.w = pk2(s[6 * 65], s[7 * 65]);
        *(v4u*)(WT + (size_t)(n0 + n) * K + k0 + 8 * c) = o; }
    LDS_WAIT(); asm volatile("" ::: "memory");
}
struct ColId { __device__ __forceinline__ int operator()(int n) const { return n; } };
struct ColW13 { __device__ __forceinline__ int operator()(int n) const { return ((n & 255) >> 7) * 5632 + (n >> 8) * 128 + (n & 127); } };
__device__ __forceinline__ int rope_src(int j) { const int grp = j >> 5, jj = j & 31; return grp * 32 + (jj & 1) * 16 + (jj >> 1); }
struct ColWin { __device__ __forceinline__ int operator()(int n) const {
    if (n < 1024) return n; if (n < 4096) return 1088 + (n - 1024); if (n < 8192) return 4160 + (n - 4096); if (n < 8256) return 1024 + rope_src(n - 8192); return -1; } };
struct ColWuq { __device__ __forceinline__ int operator()(int n) const { const int h = n / 192, w = n - h * 192; return w < 128 ? n : h * 192 + 128 + rope_src(w - 128); } };

__device__ __forceinline__ void mod_unit(int unit, const float* w_mod, const float* b_mod, float* mods, const LAS float* sc  , LAS float* red  , int tid) {
    const int lane = tid & 63, wv = tid >> 6, col = unit * 64 + lane;
    float a0 = 0.f, a1 = 0.f;
    const float* wp = w_mod + (size_t)(wv * 256) * 18432 + col;
#pragma unroll 16
    for (int k = 0; k < 256; ++k) { const float w = wp[(size_t)k * 18432]; a0 += sc[wv * 256 + k] * w; a1 += sc[2048 + wv * 256 + k] * w; }
    red[(wv * 2 + 0) * 64 + lane] = a0; red[(wv * 2 + 1) * 64 + lane] = a1;
    __syncthreads();
    if (tid < 128) { const int v = tid >> 6; float s = b_mod[col];
#pragma unroll
        for (int w = 0; w < 8; ++w) s += red[(w * 2 + v) * 64 + lane];
        mods[v * 18432 + col] = s; }
    __syncthreads();
}
__device__ __forceinline__ void filter_unit(int unit, const float* w1, const float* b1, const float* w2, const float* b2, const float* w3, const float* freq, float* hfilt, LAS float* Z  , LAS float* H1  , LAS float* H2  , int tid) {
    const int t0 = (unit >> 2) * 64, oq = unit & 3, lane = tid & 63, wv = tid >> 6;
#pragma unroll 1
    for (int idx = tid; idx < 33 * 64; idx += 512) {
        const int i = idx >> 6, t = t0 + (idx & 63); float val;
        if (i == 0) val = (float)t / 8191.0f;
        else { const int b = (i - 1) & 15; const double band = 1e-4 + (double)b * ((15.0 - 1e-4) / 15.0); double rv = band * (double)t * (1.0 / 8192.0); rv -= floor(rv);
               const float ang = 6.283185307179586f * (float)rv; val = i <= 16 ? cosf(ang) : -sinf(ang); }
        Z[idx] = val;
    }
    __syncthreads();
    {   float acc[8];
#pragma unroll
        for (int q = 0; q < 8; ++q) acc[q] = b1[wv * 8 + q];
#pragma unroll 1
        for (int i = 0; i < 33; ++i) { const float zv = Z[i * 64 + lane];
#pragma unroll
            for (int q = 0; q < 8; ++q) acc[q] += zv * w1[i * 64 + wv * 8 + q]; }
#pragma unroll
        for (int q = 0; q < 8; ++q) H1[(wv * 8 + q) * 64 + lane] = sinf(freq[wv * 8 + q] * acc[q]);
    }
    __syncthreads();
    {   float acc[8];
#pragma unroll
        for (int q = 0; q < 8; ++q) acc[q] = b2[wv * 8 + q];
#pragma unroll 2
        for (int i = 0; i < 64; ++i) { const float hv = H1[i * 64 + lane];
#pragma unroll
            for (int q = 0; q < 8; ++q) acc[q] += hv * w2[i * 64 + wv * 8 + q]; }
#pragma unroll
        for (int q = 0; q < 8; ++q) H2[(wv * 8 + q) * 64 + lane] = sinf(freq[wv * 8 + q] * acc[q]);
    }
    __syncthreads();
    const int t = t0 + lane; const float dist = fabsf((float)t - 4096.0f) * (1.0f / 4096.0f);
#pragma unroll 1
    for (int it = 0; it < 8; ++it) {
        const int oc0 = oq * 512 + wv * 64 + it * 8; float acc[8];
#pragma unroll
        for (int q = 0; q < 8; ++q) acc[q] = 0.f;
#pragma unroll 2
        for (int j = 0; j < 64; ++j) { const float hv = H2[j * 64 + lane];
#pragma unroll
            for (int q = 0; q < 8; ++q) acc[q] += hv * w3[j * 2048 + oc0 + q]; }
#pragma unroll
        for (int q = 0; q < 8; ++q) { const int oc = oc0 + q, ch = oc & 1023;
            const float decay = fabsf(-3.0701134573253944f + (-15.350567286626973f + 3.0701134573253944f) * ((float)ch * (1.0f / 1023.0f)));
            hfilt[(size_t)oc * 8192 + t] = acc[q] * (__expf(-dist * decay) + 0.05f); }
    }
    __syncthreads();
}
__device__ __forceinline__ void norm_vals_bf16(const v4f (&v)[8], const float* g, const float* shift, const float* scale, bf16* orow, int lane) {
    float s = 0.f;
#pragma unroll
    for (int j = 0; j < 8; ++j) s += (v[j][0] * v[j][0] + v[j][1] * v[j][1]) + (v[j][2] * v[j][2] + v[j][3] * v[j][3]);
    const float rstd = 1.0f / sqrtf(wave_sum(s) * (1.0f / 2048.0f) + 1e-6f);
    v2u* o8 = (v2u*)orow + lane;
#pragma unroll
    for (int j = 0; j < 8; ++j) { const v4f gg = ((const v4f*)g)[lane + 64 * j], sh = ((const v4f*)shift)[lane + 64 * j], scl = ((const v4f*)scale)[lane + 64 * j];
        const v4f y = v[j] * rstd * gg * (scl + 1.0f) + sh; v2u w; w.x = pk2(y[0], y[1]); w.y = pk2(y[2], y[3]); o8[64 * j] = w; }
}
__device__ __forceinline__ void norm_row_bf16(const float* xrow, const float* g, const float* shift, const float* scale, bf16* orow, int lane) {
    const v4f* xr = (const v4f*)xrow + lane; v4f v[8];
#pragma unroll
    for (int j = 0; j < 8; ++j) v[j] = xr[64 * j];
    norm_vals_bf16(v, g, shift, scale, orow, lane);
}
__device__ __forceinline__ void final_norm_row(float* xrow, const float* g, int lane) {
    v4f* xr = (v4f*)xrow + lane; v4f v[8]; float s = 0.f;
#pragma unroll
    for (int j = 0; j < 8; ++j) { v[j] = xr[64 * j]; s += (v[j][0] * v[j][0] + v[j][1] * v[j][1]) + (v[j][2] * v[j][2] + v[j][3] * v[j][3]); }
    const float rstd = 1.0f / sqrtf(wave_sum(s) * (1.0f / 2048.0f) + 1e-6f);
#pragma unroll
    for (int j = 0; j < 8; ++j) xr[64 * j] = v[j] * rstd * ((const v4f*)g)[lane + 64 * j];
}
__device__ __forceinline__ void transpose_item(const bf16* hyo, bf16* hytok, int item, LAS unsigned short* scr  , int lane) {
    const int cb = item >> 7, tb = item & 127, c0 = cb * 64, t0 = tb * 64;
#pragma unroll 8
    for (int i = 0; i < 32; ++i) { const int ch = 2 * i + (lane >> 5); const unsigned val = *(const unsigned*)(hyo + (size_t)(c0 + ch) * 8192 + t0 + 2 * (lane & 31));
        *(LAS unsigned*)(scr + ch * 66 + 2 * (lane & 31)) = val; }
    LDS_WAIT(); asm volatile("" ::: "memory");
    const int q = lane & 7;
#pragma unroll
    for (int it = 0; it < 8; ++it) { const int t = 8 * it + (lane >> 3); const LAS unsigned short* s = scr + (8 * q) * 66 + t;
        v4u o; o.x = (unsigned)s[0] | ((unsigned)s[66] << 16); o.y = (unsigned)s[2 * 66] | ((unsigned)s[3 * 66] << 16); o.z = (unsigned)s[4 * 66] | ((unsigned)s[5 * 66] << 16); o.w = (unsigned)s[6 * 66] | ((unsigned)s[7 * 66] << 16);
        *(v4u*)(hytok + (size_t)(t0 + t) * 1024 + c0 + 8 * q) = o; }
    LDS_WAIT(); asm volatile("" ::: "memory");
}


typedef GAS unsigned gu32;
__device__ __forceinline__ unsigned long long rt() { return __builtin_amdgcn_s_memrealtime(); }
#define XB_TMO      128
#define XB_XCNT(j)  (256  + 64 * (j))
#define XB_XSUB(j)  (1280 + 64 * (j))
#define XB_XGEN(j)  (2304 + 64 * (j))
#define XB_TOP      3328
#define XB_TOPGEN   3392
#define XCD_BAR_WORDS 3456
#define XB_SPIN_CAP (1u << 18)

__device__ __forceinline__ unsigned xb_ld(unsigned* p)              { return __hip_atomic_load(p, __ATOMIC_RELAXED, __HIP_MEMORY_SCOPE_AGENT); }
__device__ __forceinline__ unsigned xb_add(unsigned* p, unsigned v) { return __hip_atomic_fetch_add(p, v, __ATOMIC_RELAXED, __HIP_MEMORY_SCOPE_AGENT); }
__device__ __forceinline__ unsigned xb_xcc_id() { return (unsigned)__builtin_amdgcn_s_getreg((3 << 11) | 20) & 0xFu; }
#define XB_SPIN(cond, bar) do { unsigned _sp = 0; while (cond) { __builtin_amdgcn_s_sleep(1); \
    if ((++_sp & 255u) == 0u) { if (xb_ld(&(bar)[XB_TMO])) break; if (_sp > XB_SPIN_CAP) { atomicAdd(&(bar)[XB_TMO], 1u); break; } } } } while (0)

struct XcdBarrier {
    unsigned* bar; unsigned x;
    volatile LAS unsigned* st;
};

__device__ __forceinline__ XcdBarrier xcd_barrier_post(unsigned* bar, volatile LAS unsigned* st, const bool t0) {
    XcdBarrier b; b.bar = bar; b.x = xb_xcc_id(); b.st = st;
    if (t0) (void)xb_add(&bar[XB_XCNT(b.x)], 1u);
    return b;
}
__device__ __forceinline__ void xcd_barrier_complete(unsigned* bar, unsigned x, unsigned& nloc, unsigned& nx) {
    const unsigned G = gridDim.x * gridDim.y * gridDim.z;
    unsigned sum, cnt, mine, sp = 0u;
    for (;;) {
        sum = 0u; cnt = 0u; mine = 0u;
#pragma unroll
        for (unsigned j = 0; j < 16; ++j) { const unsigned c = xb_ld(&bar[XB_XCNT(j)]); sum += c; cnt += (c > 0u) ? 1u : 0u; mine = (j == x) ? c : mine; }
        if (sum == G) break;
        __builtin_amdgcn_s_sleep(1);
        if ((++sp & 255u) == 0u) { if (xb_ld(&bar[XB_TMO])) break; if (sp > XB_SPIN_CAP) { atomicAdd(&bar[XB_TMO], 1u); break; } }
    }
    nloc = mine > 0u ? mine : 1u; nx = cnt > 0u ? cnt : 1u;
}

__device__ __forceinline__ void xcd_barrier(const XcdBarrier& b, const bool t0) {
    asm volatile("s_waitcnt vmcnt(0)" ::: "memory");
    __syncthreads();
    if (t0) {
        unsigned* bar = b.bar;
        __builtin_amdgcn_s_waitcnt(0);
        unsigned nloc = b.st[0], nx = b.st[1];
        if (nloc == 0u) { xcd_barrier_complete(bar, b.x, nloc, nx); b.st[0] = nloc; b.st[1] = nx; }
        const unsigned old = xb_add(&bar[XB_XSUB(b.x)], 1u);
        const unsigned gen = old / nloc;
        if (old + 1u == (gen + 1u) * nloc) {
            __builtin_amdgcn_fence(__ATOMIC_RELEASE, "agent");
            asm volatile("s_waitcnt vmcnt(0)" ::: "memory");
            const unsigned og = xb_add(&bar[XB_TOP], 1u);
            const unsigned tg = og / nx;
            if (og + 1u == (tg + 1u) * nx) xb_add(&bar[XB_TOPGEN], 1u);
            else XB_SPIN(xb_ld(&bar[XB_TOPGEN]) == tg, bar);
            __builtin_amdgcn_fence(__ATOMIC_ACQUIRE, "agent");
            xb_add(&bar[XB_XGEN(b.x)], 1u);
            asm volatile("s_waitcnt vmcnt(0)" ::: "memory");
        } else {
            XB_SPIN(xb_ld(&bar[XB_XGEN(b.x)]) == gen, bar);
            __builtin_amdgcn_fence(__ATOMIC_ACQUIRE, "agent");
            asm volatile("s_waitcnt vmcnt(0)" ::: "memory");
        }
    }
    __syncthreads();
}

namespace cg = cooperative_groups;
struct Args { const float* in[31]; float* dst; unsigned char* ws; };
enum { I_X = 0, I_C, I_CTX, I_CCTX, I_WMOD, I_BMOD, I_GFFN1, I_W13A, I_W2A, I_GMIX, I_WIN, I_GQ, I_WUQ, I_GKV, I_WUKV, I_WAO, I_HCW, I_HCB, I_HW1, I_HB1, I_HW2, I_HB2, I_HW3, I_HFREQ, I_HSKIP, I_WHO, I_WOUT, I_GFFN2, I_W13B, I_W2B, I_GFINAL };

template <int PH_LO, int PH_HI>
__global__ void __launch_bounds__(512, 2) mk_fwd(Args args) {
    extern __shared__ __attribute__((aligned(16))) unsigned char lds_raw[];
    LAS unsigned char* lds = (LAS unsigned char*)lds_raw;
    const int wave = __builtin_amdgcn_readfirstlane((int)threadIdx.x >> 6);
#define PHASE_TID() const int lane = lane_id_fresh(), tid = wave * 64 + lane; (void)tid; (void)lane
    const int G = gridDim.x, bx = blockIdx.x;
    const int vcu = (G % 8 == 0) ? (bx % 8) * (G / 8) + bx / 8 : bx;
    const int gw = vcu * 8 + wave, NGW = G * 8;
    typedef const __attribute__((address_space(4))) Args* kargp_t;
    const kargp_t kp0 = (kargp_t)__builtin_amdgcn_kernarg_segment_ptr();
#define KP() ({ kargp_t p_ = kp0; asm volatile("" : "+s"(p_)); p_; })
#define WSB(off) (KP()->ws + (off))
#define INP(i) (KP()->in[i])
#define mods ((float*)WSB(WS_MODS))
#define rope ((float*)WSB(WS_ROPE))
#define qss ((float*)WSB(WS_QSS))
#define kvss ((float*)WSB(WS_KVSS))
#define W13A ((bf16*)WSB(WS_W13A))
#define W2A ((bf16*)WSB(WS_W2A))
#define WIN ((bf16*)WSB(WS_WIN))
#define WUQ ((bf16*)WSB(WS_WUQ))
#define WUKV ((bf16*)WSB(WS_WUKV))
#define WAO ((bf16*)WSB(WS_WAO))
#define WHO ((bf16*)WSB(WS_WHO))
#define WOUT ((bf16*)WSB(WS_WOUT))
#define W13B ((bf16*)WSB(WS_W13B))
#define W2B ((bf16*)WSB(WS_W2B))
#define HN ((bf16*)WSB(WS_HN))
#define ACT ((bf16*)WSB(WS_ACT))
#define X1 ((float*)WSB(WS_X1))
#define HYT ((bf16*)WSB(WS_HYT))
#define KV ((bf16*)WSB(WS_KV))
#define Q ((bf16*)WSB(WS_Q))
#define T ((float*)WSB(WS_T))
#define HYO ((bf16*)WSB(WS_HYO))
#define AX ((bf16*)WSB(WS_AX))
#define GATES ((bf16*)WSB(WS_GATES))
#define PQ ((bf16*)WSB(WS_PQ))
#define PKV ((bf16*)WSB(WS_PKV))
#define KR ((bf16*)WSB(WS_KR))
#define HYTOK ((bf16*)WSB(WS_HYTOK))
#define Y ((bf16*)WSB(WS_Y))
#define out (KP()->dst)
#define hfilt (KP()->dst)
    {   const int t0_ = wave * 64 + lane_id_fresh();
        for (int u = t0_; u < 128; u += 512) ((LAS unsigned*)(lds + LDS_CTL_OFF))[u] = 0u;
        __syncthreads(); }
    XcdBarrier bar = xcd_barrier_post((unsigned*)(kp0->ws + WS_CTL) + 4096, (volatile LAS unsigned*)(lds + LDS_CTL_OFF) + 8, wave == 0 && lane_id_fresh() == 0);
    constexpr int lo = PH_LO, hi = PH_HI;
#ifndef PHASE_MASK
#define PHASE_MASK 0x3fff
#endif
#define IN(k) ((((PHASE_MASK) >> (k)) & 1) && lo <= (k) && (k) < hi)
#ifndef REPEAT_PHASE
#define REPEAT_PHASE -1
#endif
#define REP(k) for (int rep_ = 0; rep_ < ((k) == REPEAT_PHASE ? 2 : 1); ++rep_)
#define SEAM(k) do { if (IN(k) && IN((k) + 1)) { if ((k) == 0) cg::this_grid().sync(); else xcd_barrier(bar, wave == 0 && lane_id_fresh() == 0); } } while (0)

    if (IN(0)) REP(0) {
        PHASE_TID();
        LAS float* sc = (LAS float*)lds; LAS float* red = (LAS float*)(lds + 16384);
        for (int i = tid; i < 4096; i += 512) { const float v = i < 2048 ? INP(I_C)[i] : INP(I_CCTX)[i - 2048]; sc[i] = v * fast_sigmoid(v); }
        __syncthreads();
        for (int u = bx; u < 288; u += G) mod_unit(u, INP(I_WMOD), INP(I_BMOD), mods, sc, red, tid);
        __syncthreads();
        if (bx == 0) for (int idx = tid; idx < 2048; idx += 512) { const int pos = idx >> 4, p = idx & 15; const float inv = powf(10000.0f, -(float)p * (1.0f / 16.0f)); const float ang = (float)pos * inv;
            rope[2 * idx] = cosf(ang); rope[2 * idx + 1] = sinf(ang); }
        {   LAS float* scr = (LAS float*)(lds + wave * 16640);
            constexpr int I13 = 32 * 176, I2 = 88 * 32, IIN = 32 * 132, IUQ = 8 * 48, IUKV = 8 * 64, IAO = 32 * 32, IHO = 16 * 32, IOUT = 32 * 32;
            constexpr int NITEMS = 2 * I13 + 2 * I2 + IIN + IUQ + IUKV + IAO + IHO + IOUT;
            for (int it = gw; it < NITEMS; it += NGW) {
                int r = it;
                if (r < I13) { cvt_item(INP(I_W13A), 2048, 11264, W13A, 176, ColW13(), nullptr, scr, r, lane); continue; } r -= I13;
                if (r < I2) { cvt_item(INP(I_W2A), 5632, 2048, W2A, 32, ColId(), nullptr, scr, r, lane); continue; } r -= I2;
                if (r < IIN) { cvt_item(INP(I_WIN), 2048, 8256, WIN, 132, ColWin(), nullptr, scr, r, lane); continue; } r -= IIN;
                if (r < IUQ) { cvt_item(INP(I_WUQ), 512, 3072, WUQ, 48, ColWuq(), INP(I_GQ), scr, r, lane); continue; } r -= IUQ;
                if (r < IUKV) { cvt_item(INP(I_WUKV), 512, 4096, WUKV, 64, ColId(), INP(I_GKV), scr, r, lane); continue; } r -= IUKV;
                if (r < IAO) { cvt_item(INP(I_WAO), 2048, 2048, WAO, 32, ColId(), nullptr, scr, r, lane); continue; } r -= IAO;
                if (r < IHO) { cvt_item(INP(I_WHO), 1024, 2048, WHO, 32, ColId(), nullptr, scr, r, lane); continue; } r -= IHO;
                if (r < IOUT) { cvt_item(INP(I_WOUT), 2048, 2048, WOUT, 32, ColId(), nullptr, scr, r, lane); continue; } r -= IOUT;
                if (r < I13) { cvt_item(INP(I_W13B), 2048, 11264, W13B, 176, ColW13(), nullptr, scr, r, lane); continue; } r -= I13;
                cvt_item(INP(I_W2B), 5632, 2048, W2B, 32, ColId(), nullptr, scr, r, lane);
            }
        }
        __syncthreads();
        for (int u = bx; u < 512; u += G)
            filter_unit(u, INP(I_HW1), INP(I_HB1), INP(I_HW2), INP(I_HB2), INP(I_HW3), INP(I_HFREQ), hfilt, (LAS float*)lds, (LAS float*)(lds + 16384), (LAS float*)(lds + 32768), tid);
    }
    SEAM(0);
    if (IN(1)) REP(1) {
        PHASE_TID();
        for (int row = gw; row < MTOT; row += NGW) {
            const bool isc = row >= SEQ; const float* src = isc ? INP(I_CTX) + (size_t)(row - SEQ) * DM : INP(I_X) + (size_t)row * DM; const float* mv = mods + (isc ? 18432 : 0);
            norm_row_bf16(src, INP(I_GFFN1), mv + 0 * DM, mv + 1 * DM, HN + (size_t)row * DM, lane);
        }
    }
    SEAM(1);
    if (IN(2)) REP(2) {
        PHASE_TID();
        pg8::Gemm g{HN, W13A, MTOT, 11264, 2048}; pg8::StaticOrder S; S.init(MTOT, 11264, G, bx);
        pg8::EpiSwiGLU E{ACT, DFF};
        pg8::gemm_phase<pg8::EpiSwiGLU, pg8::StaticOrder, true, true>(lds, g, S, E, tid);
    }
    SEAM(2);
    if (IN(3)) REP(3) {
        PHASE_TID();
        {   pg8::Gemm g{ACT, W2A, SEQ, 2048, DFF}; pg8::StaticOrder S; S.init(SEQ, 2048, G, bx);
            pg8::EpiResid E{INP(I_X), INP(I_CTX), mods + 2 * DM, mods + 18432 + 2 * DM, X1, 0.5f};
            pg8::gemm_phase<pg8::EpiResid, pg8::StaticOrder, true, true>(lds, g, S, E, tid); }
        {
            pg8::Gemm g{ACT + (size_t)SEQ * DFF, W2A, 256, 2048, 512, DFF, 512 * 2}; pg8::SplitKOrder S; S.init(11, 8, G, G - 1 - bx);
            pg8::EpiSlab E{(float*)WSB(WS_KV)};
            pg8::gemm_phase<pg8::EpiSlab, pg8::SplitKOrder, true, true>(lds, g, S, E, tid); }
    }
    SEAM(3);
    if (IN(4)) REP(4) {
        PHASE_TID();
        for (int row = gw; row < MTOT; row += NGW) {
            if (row < SEQ) { norm_row_bf16(X1 + (size_t)row * DM, INP(I_GMIX), mods + 3 * DM, mods + 4 * DM, HN + (size_t)row * DM, lane); }
            else {
                const float* mv = mods + 18432; const v4f* cr = (const v4f*)(INP(I_CTX) + (size_t)(row - SEQ) * DM) + lane; const v4f* sl = (const v4f*)((const float*)WSB(WS_KV) + (size_t)(row - SEQ) * DM) + lane;
                v4f v[8];
#pragma unroll
                for (int j = 0; j < 8; ++j) { v4f a = sl[64 * j];
#pragma unroll
                    for (int s = 1; s < 11; ++s) a += sl[(size_t)s * (256 * 2048 / 4) + 64 * j];
                    v[j] = cr[64 * j] + a * (((const v4f*)(mv + 2 * DM))[lane + 64 * j] * 0.5f); }
                norm_vals_bf16(v, INP(I_GMIX), mv + 3 * DM, mv + 4 * DM, HN + (size_t)row * DM, lane);
            }
        }
    }
    SEAM(4);
    if (IN(5)) REP(5) {
        PHASE_TID();
        pg8::Gemm g{HN, WIN, MTOT, NINP, 2048}; pg8::InProjOrder S; S.init(G, bx);
        pg8::EpiInProj E{PQ, PKV, KR, HYT, GATES, qss, kvss, rope};
        pg8::gemm_phase<pg8::EpiInProj, pg8::InProjOrder, true, true>(lds, g, S, E, tid);
    }
    SEAM(5);
    if (IN(6)) REP(6) {
        PHASE_TID();
        {   pg8::Gemm g{PQ, WUQ, SEQ, 3072, 512}; pg8::StaticOrder S; S.init(SEQ, 3072, G, bx);
            pg8::EpiQUp E{Q, qss, rope};
            pg8::gemm_phase<pg8::EpiQUp, pg8::StaticOrder, true, true>(lds, g, S, E, tid); }
        {   pg8::Gemm g{PKV, WUKV, MTOT, 4096, 512}; pg8::StaticOrder S; S.init(MTOT, 4096, G, bx);
            pg8::EpiKVUp E{KV, kvss};
            pg8::gemm_phase<pg8::EpiKVUp, pg8::StaticOrder, true, true>(lds, g, S, E, tid); }
        __syncthreads();
        for (int c = bx; c < HYW; c += G) hyena_unit(c, HYT, INP(I_HCW), INP(I_HCB), hfilt, INP(I_HSKIP), HYO, lds, tid);
    }
    SEAM(6);
    if (IN(7)) REP(7) {
        PHASE_TID();
        for (int i = 0; ; ++i) {
            const int u = i * G + vcu; if (u >= HEADS * (SEQ / 256)) break;
            const int head = u >> 5, qb = u & 31;
            { const bf16* kvb = KV; att::attn_unit(Q + (size_t)(qb * 256) * 3072 + head * DQH, kvb, kvb + head * 256, KR, AX + (size_t)(qb * 256) * DM + head * DVH, MTOT, (LAS char*)lds, tid); }
        }
        __syncthreads();
        LAS unsigned short* scr = (LAS unsigned short*)(lds + wave * 16384);
        for (int it = gw; it < 2048; it += NGW) transpose_item(HYO, HYTOK, it, scr, lane);
    }
    SEAM(7);
    if (IN(8)) REP(8) {
        PHASE_TID();
        pg8::StaticOrder S; S.init(SEQ, 2048, G, bx);
        {   pg8::Gemm g{AX, WAO, SEQ, 2048, 2048}; pg8::EpiMerge<0> E{GATES, T, Y};
            pg8::gemm_phase<pg8::EpiMerge<0>, pg8::StaticOrder, true, true>(lds, g, S, E, tid); }
        {   pg8::Gemm g{HYTOK, WHO, SEQ, 2048, 1024}; pg8::EpiMerge<1> E{GATES, T, Y};
            pg8::gemm_phase<pg8::EpiMerge<1>, pg8::StaticOrder, true, true>(lds, g, S, E, tid); }
    }
    SEAM(8);
    if (IN(9)) REP(9) {
        PHASE_TID();
        pg8::Gemm g{Y, WOUT, SEQ, 2048, 2048}; pg8::StaticOrder S; S.init(SEQ, 2048, G, bx);
        pg8::EpiResid E{X1, X1, mods + 5 * DM, mods + 5 * DM, out, 1.0f};
        pg8::gemm_phase<pg8::EpiResid, pg8::StaticOrder, true, true>(lds, g, S, E, tid);
    }
    SEAM(9);
    if (IN(10)) REP(10) {
        PHASE_TID();
        for (int row = gw; row < SEQ; row += NGW) norm_row_bf16(out + (size_t)row * DM, INP(I_GFFN2), mods + 6 * DM, mods + 7 * DM, HN + (size_t)row * DM, lane);
    }
    SEAM(10);
    if (IN(11)) REP(11) {
        PHASE_TID();
        pg8::Gemm g{HN, W13B, SEQ, 11264, 2048}; pg8::StaticOrder S; S.init(SEQ, 11264, G, bx);
        pg8::EpiSwiGLU E{ACT, DFF};
        pg8::gemm_phase<pg8::EpiSwiGLU, pg8::StaticOrder, true, true>(lds, g, S, E, tid);
    }
    SEAM(11);
    if (IN(12)) REP(12) {
        PHASE_TID();
        pg8::Gemm g{ACT, W2B, SEQ, 2048, DFF}; pg8::StaticOrder S; S.init(SEQ, 2048, G, bx);
        pg8::EpiResid E{out, out, mods + 8 * DM, mods + 8 * DM, out, 0.5f};
        pg8::gemm_phase<pg8::EpiResid, pg8::StaticOrder, true, true>(lds, g, S, E, tid);
    }
    SEAM(12);
    if (IN(13)) REP(13) {
        PHASE_TID();
        for (int row = gw; row < SEQ; row += NGW) final_norm_row(out + (size_t)row * DM, INP(I_GFINAL), lane);
    }
#undef IN
#undef SEAM
#undef PHASE_TID
#undef KP
#undef WSB
#undef INP
#undef mods
#undef rope
#undef qss
#undef kvss
#undef W13A
#undef W2A
#undef WIN
#undef WUQ
#undef WUKV
#undef WAO
#undef WHO
#undef WOUT
#undef W13B
#undef W2B
#undef HN
#undef ACT
#undef X1
#undef HYT
#undef KV
#undef Q
#undef T
#undef HYO
#undef AX
#undef GATES
#undef PQ
#undef PKV
#undef KR
#undef HYTOK
#undef Y
#undef out
#undef hfilt
}


#ifdef DBG_STOP
struct DumpArgs { const void* p[4]; size_t n[4]; int isbf[4]; float* out; size_t nout; };
__global__ void __launch_bounds__(256) dbg_dump(DumpArgs d) {
    for (size_t i = blockIdx.x * 256ull + threadIdx.x; i < d.nout; i += (size_t)gridDim.x * 256ull) {
        float s = 0.f;
        for (int b = 0; b < 4; ++b) { if (!d.p[b]) continue;
            for (size_t j = i; j < d.n[b]; j += d.nout) s += d.isbf[b] ? bf2f(((const unsigned short*)d.p[b])[j]) : ((const float*)d.p[b])[j]; }
        d.out[i] = s;
    }
}
#endif
typedef void (*kern_t)(Args);
template <int K> struct PhaseTab { static void fill(kern_t* t) { t[K] = mk_fwd<K, K + 1>; PhaseTab<K - 1>::fill(t); } };
template <> struct PhaseTab<-1> { static void fill(kern_t*) {} };
extern "C" void kernel_launch(void* const* d_in, const int* in_sizes, int n_in, void* d_out, int out_size, void* d_ws, size_t ws_size, hipStream_t stream) {
    static int grid = 0;
    static kern_t tab[N_PHASES];
    if (grid == 0) {
        if (n_in != 31 || in_sizes[0] != SEQ * DM || out_size != SEQ * DM || ws_size < WS_END) {
            fprintf(stderr, "kernel_launch: unexpected problem: n_in %d in0 %d out %d ws %zu (need %zu); nothing launched\n", n_in, n_in > 0 ? in_sizes[0] : -1, out_size, ws_size, (size_t)WS_END); grid = -1; return; }
        int dev = 0, cus = 0;
        if (hipGetDevice(&dev) != hipSuccess || hipDeviceGetAttribute(&cus, hipDeviceAttributeMultiprocessorCount, dev) != hipSuccess) { grid = -1; return; }
#if MK_N_LAUNCHES == 1
        if (hipFuncSetAttribute((const void*)mk_fwd<0, N_PHASES>, hipFuncAttributeMaxDynamicSharedMemorySize, LDS_BYTES) != hipSuccess) { fprintf(stderr, "kernel_launch: hipFuncSetAttribute failed\n"); grid = -1; return; }
        int per_cu = 0;
        if (hipOccupancyMaxActiveBlocksPerMultiprocessor(&per_cu, (const void*)mk_fwd<0, N_PHASES>, 512, LDS_BYTES) != hipSuccess || per_cu < 1) { fprintf(stderr, "kernel_launch: occupancy query says %d blocks per CU\n", per_cu); }
#else
        PhaseTab<N_PHASES - 1>::fill(tab);
        for (int i = 0; i < N_PHASES; ++i)
            if (hipFuncSetAttribute((const void*)tab[i], hipFuncAttributeMaxDynamicSharedMemorySize, LDS_BYTES) != hipSuccess) { fprintf(stderr, "kernel_launch: hipFuncSetAttribute failed (phase %d)\n", i); grid = -1; return; }
#endif
        (void)hipGetLastError();
        grid = cus;
    }
    if (grid < 0) return;
    (void)hipMemsetAsync((char*)d_ws + WS_CTL, 0, 65536, stream);
    Args a{};
    for (int i = 0; i < 31; ++i) a.in[i] = (const float*)d_in[i];
    a.dst = (float*)d_out; a.ws = (unsigned char*)d_ws;
#if MK_N_LAUNCHES == 1
    void* kargs[] = {&a};
    hipError_t e = hipLaunchCooperativeKernel((const void*)mk_fwd<0, N_PHASES>, dim3(grid), dim3(512), kargs, LDS_BYTES, stream);
    if (e != hipSuccess) fprintf(stderr, "kernel_launch: cooperative launch failed: %s (grid %d)\n", hipGetErrorString(e), grid);
#else
#ifdef DBG_STOP
    for (int li = 0; li <= DBG_STOP; ++li) hipLaunchKernelGGL(tab[li], dim3(grid), dim3(512), LDS_BYTES, stream, a);
    {   DumpArgs d{}; unsigned char* w = (unsigned char*)d_ws; d.out = (float*)d_out; d.nout = (size_t)SEQ * DM;
#if DBG_STOP == 6
        d.p[0] = w + WS_Q; d.n[0] = (size_t)8192 * 3072; d.isbf[0] = 1; d.p[1] = w + WS_KV; d.n[1] = (size_t)MTOT * 4096; d.isbf[1] = 1; d.p[2] = w + WS_HYO; d.n[2] = (size_t)1024 * 8192; d.isbf[2] = 1;
#elif DBG_STOP == 5
        d.p[0] = w + WS_GATES; d.n[0] = (size_t)8192 * 4096; d.isbf[0] = 1; d.p[1] = w + WS_PQ; d.n[1] = (size_t)8192 * 512 + (size_t)MTOT * 512 + (size_t)MTOT * 64; d.isbf[1] = 1; d.p[2] = w + WS_HYT; d.n[2] = (size_t)3072 * 8192; d.isbf[2] = 1; d.p[3] = w + WS_QSS; d.n[3] = (size_t)MTOT * 8; d.isbf[3] = 0;
#elif DBG_STOP == 3
        d.p[0] = w + WS_X1; d.n[0] = (size_t)MTOT * 2048; d.isbf[0] = 0;
#elif DBG_STOP == 2
        d.p[0] = w + WS_ACT; d.n[0] = (size_t)MTOT * DFF; d.isbf[0] = 1;
#elif DBG_STOP == 1
        d.p[0] = w + WS_HN; d.n[0] = (size_t)MTOT * 2048; d.isbf[0] = 1;
#elif DBG_STOP == 0
        d.p[0] = w + WS_W13A; d.n[0] = (WS_HN - WS_W13A) / 2; d.isbf[0] = 1; d.p[1] = w + WS_MODS; d.n[1] = 2 * 18432; d.isbf[1] = 0; d.p[2] = w + WS_ROPE; d.n[2] = 4096; d.isbf[2] = 0;
#elif DBG_STOP == 7
        d.p[0] = w + WS_AX; d.n[0] = (size_t)8192 * 2048; d.isbf[0] = 1; d.p[1] = w + WS_HYTOK; d.n[1] = (size_t)8192 * 1024; d.isbf[1] = 1;
#elif DBG_STOP == 8
        d.p[0] = w + WS_Y; d.n[0] = (size_t)8192 * 2048; d.isbf[0] = 1;
#endif
        hipLaunchKernelGGL(dbg_dump, dim3(2048), dim3(256), 0, stream, d); }
#else
    for (int li = 0; li < N_PHASES; ++li) hipLaunchKernelGGL(tab[li], dim3(grid), dim3(512), LDS_BYTES, stream, a);
#endif
    const hipError_t le = hipPeekAtLastError();
    if (le != hipSuccess) fprintf(stderr, "kernel_launch: launch failed: %s\n", hipGetErrorName(le));
#endif
}
```

```cpp
#include <hip/hip_runtime.h>
#include <hip/hip_cooperative_groups.h>
#include <cstdio>
#include <cstdint>
#include <cmath>

#ifndef MK_N_LAUNCHES
#define MK_N_LAUNCHES 1
#endif
constexpr int N_PHASES = 14;

constexpr int DM = 2048, SEQ = 8192, CTXL = 256, MTOT = SEQ + CTXL, DFF = 5632;
constexpr int HEADS = 16, QLORA = 512, KVLORA = 512, DNOPE = 128, DROPE = 64, DVH = 128, DQH = 192;
constexpr int HYW = 1024, NINP = 8448;
constexpr float NORM_EPS = 1e-6f;

constexpr size_t WS_CTL = 0;
constexpr size_t WS_MODS = 64 * 1024;
constexpr size_t WS_ROPE = 256 * 1024;
constexpr size_t WS_QSS = 320 * 1024;
constexpr size_t WS_KVSS = 640 * 1024;
constexpr size_t WS_W13A = 1u << 20;
constexpr size_t WS_W2A = WS_W13A + (size_t)11264 * 2048 * 2;
constexpr size_t WS_WIN = WS_W2A + (size_t)2048 * 5632 * 2;
constexpr size_t WS_WUQ = WS_WIN + (size_t)NINP * 2048 * 2;
constexpr size_t WS_WUKV = WS_WUQ + (size_t)3072 * 512 * 2;
constexpr size_t WS_WAO = WS_WUKV + (size_t)4096 * 512 * 2;
constexpr size_t WS_WHO = WS_WAO + (size_t)2048 * 2048 * 2;
constexpr size_t WS_WOUT = WS_WHO + (size_t)2048 * 1024 * 2;
constexpr size_t WS_W13B = WS_WOUT + (size_t)2048 * 2048 * 2;
constexpr size_t WS_W2B = WS_W13B + (size_t)11264 * 2048 * 2;
constexpr size_t WS_HN = WS_W2B + (size_t)2048 * 5632 * 2;
constexpr size_t WS_ACT = WS_HN + (size_t)MTOT * 2048 * 2;
constexpr size_t WS_X1 = WS_ACT + (size_t)MTOT * DFF * 2;
constexpr size_t WS_HYT = WS_X1 + (size_t)MTOT * 2048 * 4;
constexpr size_t WS_KV = WS_HYT + (size_t)3072 * 8192 * 2;
constexpr size_t WS_END = WS_KV + (size_t)MTOT * 4096 * 2;
constexpr size_t WS_Q = WS_W13A;
constexpr size_t WS_T = WS_W13A;
constexpr size_t WS_HYO = WS_WIN;
constexpr size_t WS_AX = WS_HN;
constexpr size_t WS_GATES = WS_ACT;
constexpr size_t WS_PQ = WS_GATES + (size_t)8192 * 4096 * 2;
constexpr size_t WS_PKV = WS_PQ + (size_t)8192 * 512 * 2;
constexpr size_t WS_KR = WS_PKV + (size_t)MTOT * 512 * 2;
constexpr size_t WS_HYTOK = WS_HYT;
constexpr size_t WS_Y = WS_KV;
static_assert(WS_KR + (size_t)MTOT * 64 * 2 <= WS_X1, "ACT overlay");
static_assert((size_t)8192 * 3072 * 2 <= WS_WIN - WS_W13A && (size_t)8192 * 2048 * 4 <= WS_WIN - WS_W13A, "Q/T overlay");

constexpr int LDS_BYTES = 163840;
constexpr int LDS_CTL_OFF = LDS_BYTES - 512;

typedef unsigned short bf16;
#define GAS __attribute__((address_space(1)))
#define LAS __attribute__((address_space(3)))
typedef unsigned v4u __attribute__((ext_vector_type(4)));
typedef unsigned v2u __attribute__((ext_vector_type(2)));
typedef float v4f __attribute__((ext_vector_type(4)));
#define LDS_WAIT() asm volatile("s_waitcnt lgkmcnt(0)" ::: "memory")
#define VM_WAIT() asm volatile("s_waitcnt vmcnt(0)" ::: "memory")
__device__ __forceinline__ unsigned f2bf(float f) { unsigned u = __builtin_bit_cast(unsigned, f); return (u + 0x7fffu + ((u >> 16) & 1u)) >> 16; }
__device__ __forceinline__ unsigned pk2(float lo, float hi) { return f2bf(lo) | (f2bf(hi) << 16); }
__device__ __forceinline__ float bf2f(unsigned short b) { return __builtin_bit_cast(float, (unsigned)b << 16); }
__device__ __forceinline__ float fast_sigmoid(float v) { return __builtin_amdgcn_rcpf(1.f + __builtin_amdgcn_exp2f(-1.4426950408889634f * v)); }
__device__ __forceinline__ float wave_sum(float v) {
#pragma unroll
    for (int o = 1; o < 64; o <<= 1) v += __shfl_xor(v, o);
    return v;
}

__device__ __forceinline__ int lane_id_fresh() { int l; asm volatile("v_mbcnt_lo_u32_b32 %0, -1, 0\n\tv_mbcnt_hi_u32_b32 %0, -1, %0" : "=v"(l)); return l; }
namespace pg8 {
#define PG8_LAS __attribute__((address_space(3)))
typedef unsigned short bf16_t;
typedef short bf16x8 __attribute__((ext_vector_type(8)));
typedef float f32x4 __attribute__((ext_vector_type(4)));
typedef unsigned u32x4 __attribute__((ext_vector_type(4)));
constexpr int BM = 256, BK = 64, HALF = 128, HTB = HALF * BK * 2  , STAGE_BYTES = 8 * HTB, NXCD = 8, WGM = 8;

__host__ __device__ __forceinline__ int lds_byte(int r, int c) { const int st = (r >> 4) * 2 + (c >> 5), rr = r & 15, cc = c & 31, ob = rr * 64 + cc * 2; return st * 1024 + (ob ^ (((ob >> 9) & 1) << 5)); }
__host__ __device__ __forceinline__ void stage_rc(int b, int& R, int& C) { const int st = b / 1024, sb = b % 1024, swz = sb ^ (((sb >> 9) & 1) << 5); R = (st >> 1) * 16 + swz / 64; C = (st & 1) * 32 + (swz % 64) / 2; }
__host__ __device__ __forceinline__ int perm32(int rho) { const int n = rho >> 4, i = rho & 15; return 8 * (i >> 2) + 4 * n + (i & 3); }

struct Unit { int pm, pn; int ks = 0; };
struct Gemm { const bf16_t* A; const bf16_t* Bt; int M, N, K; int ld = 0; size_t ksb = 0; };

struct StaticOrder {
    int nM, nN, nwg, G, c;
    __host__ __device__ void init(int M, int N, int G_, int c_) { nM = M / BM; nN = N / BM; nwg = nM * nN; G = G_; c = c_; }
    __host__ __device__ bool next(int i, Unit& u) const {
        const long L = (long)i * G + c; if (L >= nwg) return false;
        int wgid = (int)L; { const int q = nwg / NXCD, r = nwg % NXCD, xcd = wgid % NXCD, off = wgid / NXCD; wgid = (xcd < r ? xcd * (q + 1) : r * (q + 1) + (xcd - r) * q) + off; }
        const int nig = WGM * nN, gid = wgid / nig, fm = gid * WGM, gsz = (nM - fm) < WGM ? (nM - fm) : WGM;
        u.pm = fm + ((wgid % nig) % gsz); u.pn = (wgid % nig) / gsz; return true;
    }
    __device__ __forceinline__ void a_ready(const Unit&) const {}
    __device__ __forceinline__ void done(const Unit&) const {}
};


typedef float f32x2_t __attribute__((ext_vector_type(2))); typedef __bf16 bf16x2_t __attribute__((ext_vector_type(2)));
__device__ __forceinline__ unsigned cvt_pk_bf16(float lo, float hi) { f32x2_t v = {lo, hi}; bf16x2_t b = __builtin_convertvector(v, bf16x2_t); return __builtin_bit_cast(unsigned, b); }
__device__ __forceinline__ u32x4 pack8(const f32x4 v0, const f32x4 v1) { u32x4 w; w.x = cvt_pk_bf16(v0[0], v0[1]); w.y = cvt_pk_bf16(v0[2], v0[3]); w.z = cvt_pk_bf16(v1[0], v1[1]); w.w = cvt_pk_bf16(v1[2], v1[3]); return w; }
__device__ __forceinline__ float sigm(float v) { return __builtin_amdgcn_rcpf(1.f + __builtin_amdgcn_exp2f(-1.4426950408889634f * v)); }

struct EpiSwiGLU {
    static constexpr bool PERM = true, AFTER_DRAIN = false;
    bf16_t* O; int ldc;
    __device__ __forceinline__ void operator()(const f32x4 (&acc)[2][2][4][2], const Unit& u, int wr, int wc, int fr, int fq) const {
        const int row0 = u.pm * BM + wr * 64 + fr, col0 = u.pn * HALF + wc * 32 + 8 * fq;
#pragma unroll
        for (int ai = 0; ai < 2; ++ai)
#pragma unroll
            for (int m = 0; m < 4; ++m) {
                bf16_t* rowp = O + (size_t)(row0 + ai * HALF + m * 16) * ldc + col0;
                f32x4 v[2];
#pragma unroll
                for (int n = 0; n < 2; ++n)
#pragma unroll
                    for (int e = 0; e < 4; ++e) { const float a = acc[ai][0][m][n][e], b = acc[ai][1][m][n][e]; v[n][e] = a * sigm(a) * b; }
                *(u32x4*)rowp = pack8(v[0], v[1]);
            }
    }
};
struct EpiResid {
    static constexpr bool PERM = false, AFTER_DRAIN = false;
    const float* base_x; const float* base_c; const float* gate_x; const float* gate_c; float* out; float coef;
    __device__ __forceinline__ void operator()(const f32x4 (&acc)[2][2][4][2], const Unit& u, int wr, int wc, int fr, int fq) const {
        const bool isc = u.pm >= 32;
        const int row0 = u.pm * BM + wr * 64 + fr, col0 = u.pn * BM + wc * 32 + 4 * fq;
        const float* gate = isc ? gate_c : gate_x;
        f32x4 gv[2][2];
#pragma unroll
        for (int bj = 0; bj < 2; ++bj)
#pragma unroll
            for (int n = 0; n < 2; ++n) gv[bj][n] = *(const f32x4*)(gate + col0 + bj * HALF + n * 16) * coef;
#pragma unroll
        for (int ai = 0; ai < 2; ++ai)
#pragma unroll
            for (int m = 0; m < 4; ++m) {
                const int row = row0 + ai * HALF + m * 16;
                const float* bp = (isc ? base_c + (size_t)(row - 8192) * 2048 : base_x + (size_t)row * 2048) + col0;
                float* op = out + (size_t)row * 2048 + col0;
#pragma unroll
                for (int bj = 0; bj < 2; ++bj)
#pragma unroll
                    for (int n = 0; n < 2; ++n) { const f32x4 b = *(const f32x4*)(bp + bj * HALF + n * 16); *(f32x4*)(op + bj * HALF + n * 16) = b + gv[bj][n] * acc[ai][bj][m][n]; }
            }
    }
};
struct EpiInProj {
    static constexpr bool PERM = true, AFTER_DRAIN = false;
    bf16_t* pq; bf16_t* pkv; bf16_t* kr; bf16_t* hyT; bf16_t* gates; float* qss; float* kvss; const float* rope;
    __device__ __forceinline__ void operator()(const f32x4 (&acc)[2][2][4][2], const Unit& u, int wr, int wc, int fr, int fq) const {
        const int row0 = u.pm * BM + wr * 64 + fr, pn = u.pn;
        if (pn < 4) {
            bf16_t* O = pn < 2 ? pq : pkv; float* ss = pn < 2 ? qss : kvss; const int t = pn & 1;
            const int col0 = t * BM + wc * 32 + 8 * fq;
#pragma unroll
            for (int ai = 0; ai < 2; ++ai)
#pragma unroll
                for (int m = 0; m < 4; ++m) {
                    const int row = row0 + ai * HALF + m * 16; float s = 0.f;
#pragma unroll
                    for (int bj = 0; bj < 2; ++bj) {
                        const f32x4 v0 = acc[ai][bj][m][0], v1 = acc[ai][bj][m][1];
                        s += (v0[0] * v0[0] + v0[1] * v0[1]) + (v0[2] * v0[2] + v0[3] * v0[3]) + (v1[0] * v1[0] + v1[1] * v1[1]) + (v1[2] * v1[2] + v1[3] * v1[3]);
                        *(u32x4*)(O + (size_t)row * 512 + col0 + bj * HALF) = pack8(v0, v1);
                    }
                    s += __shfl_xor(s, 16); s += __shfl_xor(s, 32);
                    if (fq == 0) ss[(size_t)row * 8 + t * 4 + wc] = s;
                }
        } else if (pn < 16) {
            const int ch0 = (pn - 4) * BM + wc * 32 + 8 * fq;
#pragma unroll
            for (int ai = 0; ai < 2; ++ai)
#pragma unroll
                for (int m = 0; m < 4; ++m) {
                    const int row = row0 + ai * HALF + m * 16;
#pragma unroll
                    for (int bj = 0; bj < 2; ++bj)
#pragma unroll
                        for (int n = 0; n < 2; ++n)
#pragma unroll
                            for (int e = 0; e < 4; ++e) hyT[(size_t)(ch0 + bj * HALF + 4 * n + e) * 8192 + row] = (bf16_t)(cvt_pk_bf16(acc[ai][bj][m][n][e], 0.f) & 0xffffu);
                }
        } else if (pn < 32) {
            const int col0 = (pn - 16) * BM + wc * 32 + 8 * fq;
#pragma unroll
            for (int ai = 0; ai < 2; ++ai)
#pragma unroll
                for (int m = 0; m < 4; ++m) {
                    const int row = row0 + ai * HALF + m * 16;
#pragma unroll
                    for (int bj = 0; bj < 2; ++bj) {
                        f32x4 v0 = acc[ai][bj][m][0], v1 = acc[ai][bj][m][1];
#pragma unroll
                        for (int e = 0; e < 4; ++e) { v0[e] = sigm(v0[e]); v1[e] = sigm(v1[e]); }
                        *(u32x4*)(gates + (size_t)row * 4096 + col0 + bj * HALF) = pack8(v0, v1);
                    }
                }
        } else {
            if (wc < 2) {
#pragma unroll
                for (int ai = 0; ai < 2; ++ai)
#pragma unroll
                    for (int m = 0; m < 4; ++m) {
                        const int row = row0 + ai * HALF + m * 16;
                        f32x4 v[2] = {acc[ai][0][m][0], acc[ai][0][m][1]};
                        if (row < 8192) {
                            const int pos = wc == 0 ? (row >> 6) : (row & 63);
#pragma unroll
                            for (int n = 0; n < 2; ++n) {
                                const f32x4 cs = *(const f32x4*)(rope + (size_t)(pos * 16 + 4 * fq + 2 * n) * 2);
                                const float a0 = v[n][0], b0 = v[n][1], a1 = v[n][2], b1 = v[n][3];
                                v[n][0] = a0 * cs[0] - b0 * cs[1]; v[n][1] = a0 * cs[1] + b0 * cs[0];
                                v[n][2] = a1 * cs[2] - b1 * cs[3]; v[n][3] = a1 * cs[3] + b1 * cs[2];
                            }
                        }
                        *(u32x4*)(kr + (size_t)row * 64 + wc * 32 + 8 * fq) = pack8(v[0], v[1]);
                    }
            }
        }
    }
};
struct EpiQUp {
    static constexpr bool PERM = true, AFTER_DRAIN = false;
    bf16_t* Q; const float* qss; const float* rope;
    __device__ __forceinline__ void operator()(const f32x4 (&acc)[2][2][4][2], const Unit& u, int wr, int wc, int fr, int fq) const {
        const int row0 = u.pm * BM + wr * 64 + fr;
#pragma unroll
        for (int ai = 0; ai < 2; ++ai)
#pragma unroll
            for (int m = 0; m < 4; ++m) {
                const int row = row0 + ai * HALF + m * 16;
                const f32x4 s0 = *(const f32x4*)(qss + (size_t)row * 8), s1 = *(const f32x4*)(qss + (size_t)row * 8 + 4);
                const float r = 1.0f / sqrtf(((s0[0] + s0[1]) + (s0[2] + s0[3]) + (s1[0] + s1[1]) + (s1[2] + s1[3])) * (1.0f / 512.0f) + 1e-6f);
#pragma unroll
                for (int bj = 0; bj < 2; ++bj) {
                    const int c32 = u.pn * 8 + bj * 4 + wc, gt = c32 % 6;
                    f32x4 v[2] = {acc[ai][bj][m][0] * r, acc[ai][bj][m][1] * r};
                    if (gt >= 4) {
                        const int pos = gt == 4 ? (row >> 6) : (row & 63);
#pragma unroll
                        for (int n = 0; n < 2; ++n) {
                            const f32x4 cs = *(const f32x4*)(rope + (size_t)(pos * 16 + 4 * fq + 2 * n) * 2);
                            const float a0 = v[n][0], b0 = v[n][1], a1 = v[n][2], b1 = v[n][3];
                            v[n][0] = a0 * cs[0] - b0 * cs[1]; v[n][1] = a0 * cs[1] + b0 * cs[0];
                            v[n][2] = a1 * cs[2] - b1 * cs[3]; v[n][3] = a1 * cs[3] + b1 * cs[2];
                        }
                    }
                    *(u32x4*)(Q + (size_t)row * 3072 + c32 * 32 + 8 * fq) = pack8(v[0], v[1]);
                }
            }
    }
};
struct EpiKVUp {
    static constexpr bool PERM = true, AFTER_DRAIN = false;
    bf16_t* KV; const float* kvss;
    __device__ __forceinline__ void operator()(const f32x4 (&acc)[2][2][4][2], const Unit& u, int wr, int wc, int fr, int fq) const {
        const int row0 = u.pm * BM + wr * 64 + fr, col0 = u.pn * BM + wc * 32 + 8 * fq;
#pragma unroll
        for (int ai = 0; ai < 2; ++ai)
#pragma unroll
            for (int m = 0; m < 4; ++m) {
                const int row = row0 + ai * HALF + m * 16;
                const f32x4 s0 = *(const f32x4*)(kvss + (size_t)row * 8), s1 = *(const f32x4*)(kvss + (size_t)row * 8 + 4);
                const float r = 1.0f / sqrtf(((s0[0] + s0[1]) + (s0[2] + s0[3]) + (s1[0] + s1[1]) + (s1[2] + s1[3])) * (1.0f / 512.0f) + 1e-6f);
#pragma unroll
                for (int bj = 0; bj < 2; ++bj) *(u32x4*)(KV + (size_t)row * 4096 + col0 + bj * HALF) = pack8(acc[ai][bj][m][0] * r, acc[ai][bj][m][1] * r);
            }
    }
};
template <int PASS> struct EpiMerge {
    static constexpr bool PERM = true, AFTER_DRAIN = false;
    const bf16_t* gates; float* T; bf16_t* Y;
    __device__ __forceinline__ void operator()(const f32x4 (&acc)[2][2][4][2], const Unit& u, int wr, int wc, int fr, int fq) const {
        const int row0 = u.pm * BM + wr * 64 + fr, col0 = u.pn * BM + wc * 32 + 8 * fq;
#pragma unroll
        for (int ai = 0; ai < 2; ++ai)
#pragma unroll
            for (int m = 0; m < 4; ++m) {
                const int row = row0 + ai * HALF + m * 16;
#pragma unroll
                for (int bj = 0; bj < 2; ++bj) {
                    const int col = col0 + bj * HALF;
                    const u32x4 g = *(const u32x4*)(gates + (size_t)row * 4096 + PASS * 2048 + col);
                    f32x4 g0, g1;
                    g0[0] = __builtin_bit_cast(float, g.x << 16); g0[1] = __builtin_bit_cast(float, g.x & 0xffff0000u); g0[2] = __builtin_bit_cast(float, g.y << 16); g0[3] = __builtin_bit_cast(float, g.y & 0xffff0000u);
                    g1[0] = __builtin_bit_cast(float, g.z << 16); g1[1] = __builtin_bit_cast(float, g.z & 0xffff0000u); g1[2] = __builtin_bit_cast(float, g.w << 16); g1[3] = __builtin_bit_cast(float, g.w & 0xffff0000u);
                    float* tp = T + (size_t)row * 2048 + col;
                    if (PASS == 0) { *(f32x4*)tp = g0 * acc[ai][bj][m][0]; *(f32x4*)(tp + 4) = g1 * acc[ai][bj][m][1]; }
                    else { const f32x4 t0 = *(const f32x4*)tp, t1 = *(const f32x4*)(tp + 4);
                        *(u32x4*)(Y + (size_t)row * 2048 + col) = pack8(t0 + g0 * acc[ai][bj][m][0], t1 + g1 * acc[ai][bj][m][1]); }
                }
            }
    }
};
struct EpiSlab {
    static constexpr bool PERM = false, AFTER_DRAIN = false;
    float* slab;
    __device__ __forceinline__ void operator()(const f32x4 (&acc)[2][2][4][2], const Unit& u, int wr, int wc, int fr, int fq) const {
        const int row0 = wr * 64 + fr, col0 = u.pn * BM + wc * 32 + 4 * fq;
        float* base = slab + (size_t)u.ks * 256 * 2048;
#pragma unroll
        for (int ai = 0; ai < 2; ++ai)
#pragma unroll
            for (int m = 0; m < 4; ++m) {
                float* op = base + (size_t)(row0 + ai * HALF + m * 16) * 2048 + col0;
#pragma unroll
                for (int bj = 0; bj < 2; ++bj)
#pragma unroll
                    for (int n = 0; n < 2; ++n) *(f32x4*)(op + bj * HALF + n * 16) = acc[ai][bj][m][n];
            }
    }
};
struct SplitKOrder {
    int G, c, nslice, nunits;
    __host__ __device__ void init(int nslice_, int ncol, int G_, int c_) { G = G_; c = c_; nslice = nslice_; nunits = nslice_ * ncol; }
    __host__ __device__ bool next(int i, Unit& u) const { const long L = (long)i * G + c; if (L >= nunits) return false; u.pm = 0; u.pn = (int)L / nslice; u.ks = (int)L % nslice; return true; }
    __device__ __forceinline__ void a_ready(const Unit&) const {}
    __device__ __forceinline__ void done(const Unit&) const {}
};
struct InProjOrder {
    StaticOrder base; int G, c;
    __host__ __device__ void init(int G_, int c_) { base.init(8192, 8448, G_, c_); G = G_; c = c_; }
    __host__ __device__ bool next(int i, Unit& u) const {
        if (base.next(i, u)) return true;
        const long L = (long)i * G + c - base.nwg; if (L < 0 || L >= 3) return false;
        u.pm = 32; u.pn = L == 0 ? 2 : (L == 1 ? 3 : 32); return true;
    }
    __device__ __forceinline__ void a_ready(const Unit&) const {}
    __device__ __forceinline__ void done(const Unit&) const {}
};

template <class Epi, class Sched, bool ALIGN_EPI = false, bool SP2 = false>
__device__ __forceinline__ void gemm_phase(PG8_LAS unsigned char* lds, const Gemm g, const Sched& S, const Epi& E, const int tid) {
    const int wid = __builtin_amdgcn_readfirstlane(tid >> 6), lane = tid & 63, wr = wid >> 2, wc = wid & 3, fr = lane & 15, fq = lane >> 4;
    const int K = g.K, nt = K / BK, ld = g.ld ? g.ld : g.K;
    unsigned voffA[2], voffB[2];
#pragma unroll
    for (int i = 0; i < 2; ++i) { int R, C; stage_rc(tid * 16 + i * 8192, R, C); const int Rb = Epi::PERM ? ((R & ~31) + perm32(R & 31)) : R;
        voffA[i] = (unsigned)(R * ld + C) * 2u; voffB[i] = (unsigned)(Rb * ld + C) * 2u; }
    const size_t kstep = (size_t)(BK * 2);
    const size_t hstep = (size_t)HALF * ld * 2;
    const size_t tstep = 2 * hstep;
    const unsigned ldsw = (unsigned)wid * 1024u;
    const int aoff = lds_byte(wr * 64 + fr, fq * 8), boff = lds_byte(wc * 32 + fr, fq * 8);
#define PG8_SA(b, h) (((b) * 2 + (h)) * HTB)
#define PG8_SB(b, h) ((4 + (b) * 2 + (h)) * HTB)
#define PG8_STAGE(bufoff, gbase, voff) do { _Pragma("unroll") for (int _i = 0; _i < 2; ++_i) \
        __builtin_amdgcn_global_load_lds((const unsigned*)((const char*)(gbase) + (voff)[_i]), (PG8_LAS unsigned*)(lds + (bufoff) + ldsw + _i * 8192), 16, 0, 0); } while (0)
#define PG8_LDA(dst, b, h) do { _Pragma("unroll") for (int m = 0; m < 4; ++m) _Pragma("unroll") for (int k = 0; k < 2; ++k) dst[m][k] = *(const PG8_LAS bf16x8*)(lds + PG8_SA(b, h) + aoff + m * 2048 + k * 1024); } while (0)
#define PG8_LDB(dst, b, h) do { _Pragma("unroll") for (int n = 0; n < 2; ++n) _Pragma("unroll") for (int k = 0; k < 2; ++k) dst[n][k] = *(const PG8_LAS bf16x8*)(lds + PG8_SB(b, h) + boff + n * 2048 + k * 1024); } while (0)
#define PG8_MMA(ai, bj, At, Bt) do { __builtin_amdgcn_s_setprio(1); _Pragma("unroll") for (int m = 0; m < 4; ++m) _Pragma("unroll") for (int n = 0; n < 2; ++n) _Pragma("unroll") for (int k = 0; k < 2; ++k) \
        acc[ai][bj][m][n] = __builtin_amdgcn_mfma_f32_16x16x32_bf16(Bt[n][k], At[m][k], acc[ai][bj][m][n], 0, 0, 0); __builtin_amdgcn_s_setprio(0); } while (0)
#define PG8_WAIT_V(n) asm volatile("s_waitcnt vmcnt(" #n ")" ::: "memory")
#define PG8_WAIT_L(n) asm volatile("s_waitcnt lgkmcnt(" #n ")" ::: "memory")
#define PG8_BAR __builtin_amdgcn_s_barrier()
#define PG8_SCHED __builtin_amdgcn_sched_barrier(0)
    Unit cur, nxt; int ui = 0;
    if (!S.next(0, cur)) return;
    f32x4 acc[2][2][4][2];
#pragma unroll
    for (int a = 0; a < 2; ++a)
#pragma unroll
        for (int b = 0; b < 2; ++b)
#pragma unroll
            for (int m = 0; m < 4; ++m)
#pragma unroll
                for (int n = 0; n < 2; ++n) acc[a][b][m][n] = (f32x4){0.f, 0.f, 0.f, 0.f};
    bf16x8 At[4][2], B0[2][2], B1[2][2];
    const char* cA = (const char*)g.A + (size_t)cur.pm * tstep + (size_t)cur.ks * g.ksb; const char* cB = (const char*)g.Bt + (size_t)cur.pn * tstep + (size_t)cur.ks * g.ksb;
    S.a_ready(cur);
    if constexpr (SP2) {
        PG8_STAGE(PG8_SB(0, 0), cB, voffB); PG8_STAGE(PG8_SB(0, 1), cB + hstep, voffB); PG8_STAGE(PG8_SA(0, 0), cA, voffA); PG8_STAGE(PG8_SA(0, 1), cA + hstep, voffA);
        if (wr == 1) PG8_BAR;
        PG8_WAIT_V(2); PG8_BAR;
        PG8_STAGE(PG8_SB(1, 0), cB + kstep, voffB); PG8_STAGE(PG8_SA(1, 0), cA + kstep, voffA); PG8_STAGE(PG8_SB(1, 1), cB + hstep + kstep, voffB);
        PG8_WAIT_V(6); PG8_BAR;
    } else {
        PG8_STAGE(PG8_SB(0, 0), cB, voffB); PG8_STAGE(PG8_SA(0, 0), cA, voffA); PG8_STAGE(PG8_SB(0, 1), cB + hstep, voffB); PG8_STAGE(PG8_SA(0, 1), cA + hstep, voffA);
        if (wr == 1) PG8_BAR;
        PG8_WAIT_V(4); PG8_BAR;
        PG8_STAGE(PG8_SB(1, 0), cB + kstep, voffB); PG8_STAGE(PG8_SA(1, 0), cA + kstep, voffA); PG8_STAGE(PG8_SB(1, 1), cB + hstep + kstep, voffB);
        PG8_WAIT_V(6); PG8_BAR;
    }
    for (;;) {
        const bool has_next = S.next(ui + 1, nxt);
        const char* nA = has_next ? (const char*)g.A + (size_t)nxt.pm * tstep + (size_t)nxt.ks * g.ksb : cA; const char* nB = has_next ? (const char*)g.Bt + (size_t)nxt.pn * tstep + (size_t)nxt.ks * g.ksb : cB;
        for (int t = 0; t < nt; t += 2) {
            const bool last = (t == nt - 2);
            const char* a1 = cA + (size_t)(t + 1) * kstep;
            const char* a2 = last ? nA : cA + (size_t)(t + 2) * kstep; const char* b2 = last ? nB : cB + (size_t)(t + 2) * kstep;
            const char* a3 = a2 + kstep; const char* b3 = b2 + kstep;
            if (last && has_next) S.a_ready(nxt);
            if constexpr (SP2) {
            PG8_LDB(B0, 0, 0); PG8_LDB(B1, 0, 1); PG8_SCHED; PG8_LDA(At, 0, 0); PG8_STAGE(PG8_SA(1, 1), a1 + hstep, voffA);
            PG8_WAIT_V(8); PG8_WAIT_L(0); PG8_BAR; PG8_MMA(0, 0, At, B0); PG8_MMA(0, 1, At, B1); PG8_BAR; PG8_SCHED;
            PG8_LDA(At, 0, 1); PG8_STAGE(PG8_SB(0, 0), b2, voffB); PG8_STAGE(PG8_SB(0, 1), b2 + hstep, voffB); PG8_STAGE(PG8_SA(0, 0), a2, voffA);
            PG8_WAIT_V(8); PG8_WAIT_L(0); PG8_BAR; PG8_MMA(1, 0, At, B0); PG8_MMA(1, 1, At, B1); PG8_BAR; PG8_SCHED;
            PG8_LDB(B0, 1, 0); PG8_LDB(B1, 1, 1); PG8_SCHED; PG8_LDA(At, 1, 0); PG8_STAGE(PG8_SA(0, 1), a2 + hstep, voffA);
            PG8_WAIT_V(8); PG8_WAIT_L(0); PG8_BAR; PG8_MMA(0, 0, At, B0); PG8_MMA(0, 1, At, B1); PG8_BAR; PG8_SCHED;
            PG8_LDA(At, 1, 1); PG8_STAGE(PG8_SB(1, 0), b3, voffB); PG8_STAGE(PG8_SB(1, 1), b3 + hstep, voffB); PG8_STAGE(PG8_SA(1, 0), a3, voffA);
            PG8_WAIT_V(8); PG8_WAIT_L(0); PG8_BAR; PG8_MMA(1, 0, At, B0); PG8_MMA(1, 1, At, B1); PG8_BAR; PG8_SCHED;
            } else {
            PG8_LDB(B0, 0, 0); PG8_SCHED; PG8_LDA(At, 0, 0); PG8_STAGE(PG8_SA(1, 1), a1 + hstep, voffA);
            PG8_WAIT_L(8); PG8_BAR; PG8_WAIT_L(0); PG8_MMA(0, 0, At, B0); PG8_BAR; PG8_SCHED;
            PG8_LDB(B1, 0, 1); PG8_STAGE(PG8_SB(0, 0), b2, voffB);
            PG8_BAR; PG8_WAIT_L(0); PG8_MMA(0, 1, At, B1); PG8_BAR;
            PG8_LDA(At, 0, 1); PG8_STAGE(PG8_SA(0, 0), a2, voffA);
            PG8_BAR; PG8_WAIT_L(0); PG8_MMA(1, 0, At, B0); PG8_BAR; PG8_SCHED;
            PG8_STAGE(PG8_SB(0, 1), b2 + hstep, voffB);
            PG8_WAIT_V(6); PG8_BAR; PG8_MMA(1, 1, At, B1); PG8_BAR;
            PG8_LDB(B0, 1, 0); PG8_SCHED; PG8_LDA(At, 1, 0); PG8_STAGE(PG8_SA(0, 1), a2 + hstep, voffA);
            PG8_WAIT_L(8); PG8_BAR; PG8_WAIT_L(0); PG8_MMA(0, 0, At, B0); PG8_BAR; PG8_SCHED;
            PG8_LDB(B1, 1, 1); PG8_STAGE(PG8_SB(1, 0), b3, voffB);
            PG8_BAR; PG8_WAIT_L(0); PG8_MMA(0, 1, At, B1); PG8_BAR;
            PG8_LDA(At, 1, 1); PG8_STAGE(PG8_SA(1, 0), a3, voffA);
            PG8_BAR; PG8_WAIT_L(0); PG8_MMA(1, 0, At, B0); PG8_BAR; PG8_SCHED;
            PG8_STAGE(PG8_SB(1, 1), b3 + hstep, voffB);
            PG8_WAIT_V(6); PG8_BAR; PG8_MMA(1, 1, At, B1); PG8_BAR;
            }
        }
        if constexpr (ALIGN_EPI) { if (wr == 0) PG8_BAR; }
        if constexpr (!Epi::AFTER_DRAIN) { E(acc, cur, wr, wc, fr, fq); S.done(cur); }
        if (!has_next) break;
#pragma unroll
        for (int a = 0; a < 2; ++a)
#pragma unroll
            for (int b = 0; b < 2; ++b)
#pragma unroll
                for (int m = 0; m < 4; ++m)
#pragma unroll
                    for (int n = 0; n < 2; ++n) acc[a][b][m][n] = (f32x4){0.f, 0.f, 0.f, 0.f};
        cur = nxt; cA = nA; cB = nB; ++ui;
        if constexpr (ALIGN_EPI) { if (wr == 1) PG8_BAR; }
    }
    PG8_WAIT_V(0);
    if constexpr (!ALIGN_EPI) { if (wr == 0) PG8_BAR; }
    PG8_BAR;
    if constexpr (Epi::AFTER_DRAIN) { E.fused(acc, cur, wr, wc, fr, fq, lds, wid, lane); S.done(cur); }
#undef PG8_SA
#undef PG8_SB
#undef PG8_STAGE
#undef PG8_LDA
#undef PG8_LDB
#undef PG8_MMA
#undef PG8_WAIT_V
#undef PG8_WAIT_L
#undef PG8_BAR
#undef PG8_SCHED
}
}

namespace att {
using bf16x8 = __attribute__((ext_vector_type(8))) short;
using s16x4  = __attribute__((ext_vector_type(4))) short;
using f32x16 = __attribute__((ext_vector_type(16))) float;
using u32x4  = __attribute__((ext_vector_type(4))) unsigned;
constexpr int NW = 8, QBLK = 32, KVBLK = 64;
#ifndef ATT_NQREG
#define ATT_NQREG 3
#endif
#ifndef QKT_PIN
#define QKT_PIN 1
#endif
#ifndef QKT_PIN_MASK
#define QKT_PIN_MASK 3
#endif
constexpr int NQREG = ATT_NQREG, NQLDS = 12 - NQREG;
constexpr float SCALE = 0.07216878364870322f;
constexpr float THR = 8.f;
constexpr int LDQ = 3072, LDK = 4096, LDR = 64, LDO = 2048;
constexpr int SHM_V = KVBLK * 128 * 2, SHM_K = KVBLK * 128 * 2, SHM_R = KVBLK * 64 * 2;
constexpr int OFF_V = 0, OFF_K = 2 * SHM_V, OFF_R = OFF_K + 2 * SHM_K, OFF_WS = OFF_R + 2 * SHM_R, OFF_QR = OFF_WS + NW * 64 * 4, SHM_ATTN = OFF_QR + NW * NQLDS * 1024;
#define KSWZ(row, colB) ((row) * 256 + ((colB) ^ (((row) & 7) << 4)))
#define RSWZ(row, ch) ((row) * 128 + ((((ch) ^ (((row) >> 1) & 7))) << 4))
#define SBAR() __builtin_amdgcn_sched_barrier(0)
__device__ __forceinline__ int crow(int r, int hi) { return (r & 3) + 8 * (r >> 2) + 4 * hi; }
typedef float f32x2_t __attribute__((ext_vector_type(2))); typedef __bf16 bf16x2_t __attribute__((ext_vector_type(2)));
__device__ __forceinline__ unsigned cvtpk(float lo, float hi) { f32x2_t v = {lo, hi}; bf16x2_t b = __builtin_convertvector(v, bf16x2_t); return __builtin_bit_cast(unsigned, b); }

__device__ __forceinline__ void partialSM(f32x16& p0, f32x16& p1, float& m_reg, float& mn, float& alpha) {
  constexpr float C = SCALE * 1.4426950408889634f;
  float pmax = p0[0];
#pragma unroll
  for (int r = 1; r < 16; ++r) pmax = fmaxf(pmax, p0[r]);
#pragma unroll
  for (int r = 0; r < 16; ++r) pmax = fmaxf(pmax, p1[r]);
  { auto rr = __builtin_amdgcn_permlane32_swap(__float_as_uint(pmax), __float_as_uint(pmax), false, false);
    pmax = fmaxf(__uint_as_float(rr[0]), __uint_as_float(rr[1])); }
  if (__builtin_expect(__all(pmax - m_reg <= THR / SCALE), 1)) { mn = m_reg; alpha = 1.f; }
  else { mn = fmaxf(m_reg, pmax); alpha = __builtin_amdgcn_exp2f((m_reg - mn) * C); m_reg = mn; }
  float mnC = -mn * C;
#pragma unroll
  for (int r = 0; r < 16; ++r) p0[r] = fmaf(p0[r], C, mnC);
#pragma unroll
  for (int r = 0; r < 16; ++r) p1[r] = fmaf(p1[r], C, mnC);
#pragma unroll
  for (int r = 0; r < 16; ++r) p0[r] = __builtin_amdgcn_exp2f(p0[r]);
}
__device__ __forceinline__ void finishSM(f32x16& p0, f32x16& p1, float alpha, float& l_reg, bf16x8& pa0, bf16x8& pa1, bf16x8& pa2, bf16x8& pa3) {
#pragma unroll
  for (int r = 0; r < 16; ++r) p1[r] = __builtin_amdgcn_exp2f(p1[r]);
  float ps = 0;
#pragma unroll
  for (int r = 0; r < 16; ++r) ps += p0[r];
#pragma unroll
  for (int r = 0; r < 16; ++r) ps += p1[r];
  { auto rr = __builtin_amdgcn_permlane32_swap(__float_as_uint(ps), __float_as_uint(ps), false, false);
    ps = __uint_as_float(rr[0]) + __uint_as_float(rr[1]); }
  l_reg = l_reg * alpha + ps;
#define PK4(P, BASE, OUT) do { unsigned a0 = cvtpk(P[BASE + 0], P[BASE + 1]), a1 = cvtpk(P[BASE + 2], P[BASE + 3]);   \
    unsigned b0 = cvtpk(P[BASE + 4], P[BASE + 5]), b1 = cvtpk(P[BASE + 6], P[BASE + 7]);                              \
    auto r0 = __builtin_amdgcn_permlane32_swap(a0, b0, false, false); auto r1 = __builtin_amdgcn_permlane32_swap(a1, b1, false, false); \
    u32x4 w = {r0[0], r1[0], r0[1], r1[1]}; OUT = *reinterpret_cast<bf16x8*>(&w); } while (0)
  PK4(p0, 0, pa0); PK4(p0, 8, pa1); PK4(p1, 0, pa2); PK4(p1, 8, pa3);
#undef PK4
}
typedef LAS char* lp_t; typedef const LAS char* clp_t;
__device__ __forceinline__ void qkt(f32x16& p0, f32x16& p1, clp_t Ks, clp_t Rs, const bf16x8* qr, clp_t Qr, int r32, int hi) {
  p0 = f32x16{}; p1 = f32x16{};
#pragma unroll
  for (int d0 = 0; d0 < 8; ++d0) { int cb = (d0 * 16 + hi * 8) * 2;
    bf16x8 b0 = *(const LAS bf16x8*)(Ks + KSWZ(r32, cb));
    bf16x8 b1 = *(const LAS bf16x8*)(Ks + KSWZ(32 + r32, cb));
    bf16x8 qv; if (d0 < NQREG) qv = qr[d0]; else qv = *(const LAS bf16x8*)(Qr + (d0 - NQREG) * 1024);
    p0 = __builtin_amdgcn_mfma_f32_32x32x16_bf16(b0, qv, p0, 0, 0, 0);
    p1 = __builtin_amdgcn_mfma_f32_32x32x16_bf16(b1, qv, p1, 0, 0, 0);
    if (QKT_PIN && (d0 & (QKT_PIN_MASK)) == (QKT_PIN_MASK)) SBAR(); }
#pragma unroll
  for (int d0 = 0; d0 < 4; ++d0) { int ch = d0 * 2 + hi;
    bf16x8 b0 = *(const LAS bf16x8*)(Rs + RSWZ(r32, ch));
    bf16x8 b1 = *(const LAS bf16x8*)(Rs + RSWZ(32 + r32, ch));
    bf16x8 qv; if (8 + d0 < NQREG) qv = qr[8 + d0]; else qv = *(const LAS bf16x8*)(Qr + (8 + d0 - NQREG) * 1024);
    p0 = __builtin_amdgcn_mfma_f32_32x32x16_bf16(b0, qv, p0, 0, 0, 0);
    p1 = __builtin_amdgcn_mfma_f32_32x32x16_bf16(b1, qv, p1, 0, 0, 0); }
}
__device__ __forceinline__ int v_st(int k, int c) { const int kk = (k & ~0xC) | ((k & 4) << 1) | ((k & 8) >> 1); return ((kk >> 3) * 4 + (c >> 5)) * 512 + ((kk & 7) * 32 + (c & 31)) * 2; }
__device__ __forceinline__ int v_rd_base(int lane) { return ((lane & 3) << 3) | (((lane >> 2) & 3) << 6) | (((lane >> 4) & 1) << 5) | (((lane >> 5) & 1) << 8); }
constexpr int v_rd_off(int d0, int ks, int half) { return d0 * 512 + ks * 4096 + half * 2048; }
template <int OFF> __device__ __forceinline__ s16x4 tr_read(int vb) {
  s16x4 r; asm volatile("ds_read_b64_tr_b16 %0, %1 offset:%2" : "=&v"(r) : "v"(vb), "i"(OFF) : "memory"); return r;
}
template <int D0> __device__ __forceinline__ void pv_one(f32x16& od, int vb, bf16x8 pa0, bf16x8 pa1, bf16x8 pa2, bf16x8 pa3) {
  const s16x4 l0 = tr_read<v_rd_off(D0, 0, 0)>(vb), h0 = tr_read<v_rd_off(D0, 0, 1)>(vb), l1 = tr_read<v_rd_off(D0, 1, 0)>(vb), h1 = tr_read<v_rd_off(D0, 1, 1)>(vb);
  const s16x4 l2 = tr_read<v_rd_off(D0, 2, 0)>(vb), h2 = tr_read<v_rd_off(D0, 2, 1)>(vb), l3 = tr_read<v_rd_off(D0, 3, 0)>(vb), h3 = tr_read<v_rd_off(D0, 3, 1)>(vb);
  asm volatile("s_waitcnt lgkmcnt(0)" ::: "memory"); SBAR();
#define PK(L, H) (bf16x8){L[0], L[1], L[2], L[3], H[0], H[1], H[2], H[3]}
  od = __builtin_amdgcn_mfma_f32_32x32x16_bf16(pa0, PK(l0, h0), od, 0, 0, 0);
  od = __builtin_amdgcn_mfma_f32_32x32x16_bf16(pa1, PK(l1, h1), od, 0, 0, 0);
  od = __builtin_amdgcn_mfma_f32_32x32x16_bf16(pa2, PK(l2, h2), od, 0, 0, 0);
  od = __builtin_amdgcn_mfma_f32_32x32x16_bf16(pa3, PK(l3, h3), od, 0, 0, 0);
#undef PK
}
__device__ __forceinline__ void pv_d0(f32x16* o, int vb, bf16x8 pa0, bf16x8 pa1, bf16x8 pa2, bf16x8 pa3) {
  pv_one<0>(o[0], vb, pa0, pa1, pa2, pa3); pv_one<1>(o[1], vb, pa0, pa1, pa2, pa3); pv_one<2>(o[2], vb, pa0, pa1, pa2, pa3); pv_one<3>(o[3], vb, pa0, pa1, pa2, pa3);
}
__device__ __forceinline__ void attn_unit(const unsigned short* __restrict__ Qb, const unsigned short* __restrict__ Kbase0, const unsigned short* __restrict__ Kn,
                                          const unsigned short* __restrict__ Kr, unsigned short* __restrict__ Ob, int seq, LAS char* lds, const int tid) {
  const int wid = __builtin_amdgcn_readfirstlane(tid >> 6), lane = tid & 63, r32 = lane & 31, hi = lane >> 5;
  lp_t V_lds = lds + OFF_V; lp_t K_lds = lds + OFF_K; lp_t R_lds = lds + OFF_R;
  LAS float* ws = (LAS float*)(lds + OFF_WS) + wid * 64; LAS float* li_l = ws; LAS float* al_l = ws + 32;
  float m_reg = -1e30f, l_reg = 0; f32x16 o[4] = {}; bf16x8 qr[NQREG > 0 ? NQREG : 1];
  const unsigned short* Qw = Qb + (long)(wid * QBLK + r32) * LDQ + hi * 8;
#pragma unroll
  for (int d0 = 0; d0 < NQREG; ++d0) qr[d0] = *reinterpret_cast<const bf16x8*>(Qw + d0 * 16);
  lp_t Qr = lds + OFF_QR + wid * (NQLDS * 1024) + (hi * 32 + r32) * 16;
#pragma unroll
  for (int d0 = NQREG; d0 < 12; ++d0) *(LAS bf16x8*)(Qr + (d0 - NQREG) * 1024) = *reinterpret_cast<const bf16x8*>(Qw + d0 * 16);
  const int sr = tid >> 4, sc = (tid & 15) * 8, vst0 = v_st(sr, sc), vst1 = v_st(32 + sr, sc);
  const int rk = tid >> 3, rch = tid & 7, rst = RSWZ(rk, rch);
  const int vb0 = (int)(unsigned)(uintptr_t)V_lds + v_rd_base(lane);
  bf16x8 vs0, vs1, ks0, ks1, rs0;
  const __amdgpu_buffer_rsrc_t srdKV = __builtin_amdgcn_make_buffer_rsrc((void*)Kn, (short)0, (int)(((long)seq * LDK - (Kn - Kbase0)) * 2), 0x00020000);
  const __amdgpu_buffer_rsrc_t srdR = __builtin_amdgcn_make_buffer_rsrc((void*)Kr, (short)0, (int)((long)seq * LDR * 2), 0x00020000);
  const int voffKV = (sr * LDK + sc) * 2, voffR = (rk * LDR + rch * 8) * 2;
#define BLD(srd, vo, so) __builtin_bit_cast(bf16x8, __builtin_amdgcn_raw_buffer_load_b128(srd, vo, so, 0))
#define SLOAD(k0) do { const int so_ = __builtin_amdgcn_readfirstlane((k0) * LDK * 2); \
    vs0 = BLD(srdKV, voffKV + 256, so_); vs1 = BLD(srdKV, voffKV + 256, so_ + 32 * LDK * 2); \
    ks0 = BLD(srdKV, voffKV, so_); ks1 = BLD(srdKV, voffKV, so_ + 32 * LDK * 2); \
    rs0 = BLD(srdR, voffR, __builtin_amdgcn_readfirstlane((k0) * LDR * 2)); } while (0)
#define SWRITE(b) do { *(LAS bf16x8*)(V_lds + (b) * SHM_V + vst0) = vs0; *(LAS bf16x8*)(V_lds + (b) * SHM_V + vst1) = vs1; int kc = sc * 2; \
    *(LAS bf16x8*)(K_lds + (b) * SHM_K + KSWZ(sr, kc)) = ks0; *(LAS bf16x8*)(K_lds + (b) * SHM_K + KSWZ(32 + sr, kc)) = ks1; \
    *(LAS bf16x8*)(R_lds + (b) * SHM_R + rst) = rs0; } while (0)
#define SWAIT() asm volatile("s_waitcnt vmcnt(0)" ::: "memory")
#define RESC(a) do { if (__any((a) < 1.f)) { if (hi == 0) al_l[r32] = (a); asm volatile("s_waitcnt lgkmcnt(0)" ::: "memory"); \
    _Pragma("unroll") for (int d = 0; d < 4; ++d) _Pragma("unroll") for (int r = 0; r < 16; ++r) o[d][r] *= al_l[crow(r, hi)]; } } while (0)
  f32x16 pA0, pA1, pB0, pB1; float mnA, mnB, alA, alB; bf16x8 pa0, pa1, pa2, pa3; const int NT = seq / KVBLK;
  SLOAD(0); SWAIT(); SWRITE(0); __syncthreads();
  qkt(pA0, pA1, K_lds, R_lds, qr, Qr, r32, hi); partialSM(pA0, pA1, m_reg, mnA, alA);
  SLOAD(KVBLK);
  SWAIT(); SWRITE(1); __syncthreads();
  for (int j = 1; j + 1 < NT; j += 2) {
    SBAR(); qkt(pB0, pB1, K_lds + SHM_K, R_lds + SHM_R, qr, Qr, r32, hi);
    finishSM(pA0, pA1, alA, l_reg, pa0, pa1, pa2, pa3); SBAR();
    SLOAD((j + 1) * KVBLK); SBAR();
    pv_d0(o, vb0, pa0, pa1, pa2, pa3); partialSM(pB0, pB1, m_reg, mnB, alB);
    __syncthreads(); SWAIT(); SWRITE(0);
    RESC(alB); __syncthreads();
    SBAR(); qkt(pA0, pA1, K_lds, R_lds, qr, Qr, r32, hi);
    finishSM(pB0, pB1, alB, l_reg, pa0, pa1, pa2, pa3); SBAR();
    SLOAD((j + 2) * KVBLK); SBAR();
    pv_d0(o, vb0 + SHM_V, pa0, pa1, pa2, pa3); partialSM(pA0, pA1, m_reg, mnA, alA);
    __syncthreads(); SWAIT(); SWRITE(1);
    RESC(alA); __syncthreads();
  }
  SBAR(); qkt(pB0, pB1, K_lds + SHM_K, R_lds + SHM_R, qr, Qr, r32, hi);
  finishSM(pA0, pA1, alA, l_reg, pa0, pa1, pa2, pa3); SBAR();
  pv_d0(o, vb0, pa0, pa1, pa2, pa3); partialSM(pB0, pB1, m_reg, mnB, alB);
  __syncthreads(); RESC(alB);
  finishSM(pB0, pB1, alB, l_reg, pa0, pa1, pa2, pa3); SBAR();
  pv_d0(o, vb0 + SHM_V, pa0, pa1, pa2, pa3);
  if (hi == 0) li_l[r32] = l_reg; asm volatile("s_waitcnt lgkmcnt(0)" ::: "memory");
  float rli[16];
#pragma unroll
  for (int r = 0; r < 16; ++r) rli[r] = __builtin_amdgcn_rcpf(li_l[crow(r, hi)]);
  unsigned short* Ow = Ob + (long)(wid * QBLK) * LDO;
#pragma unroll
  for (int r = 0; r < 16; ++r) { int orow = crow(r, hi);
#pragma unroll
    for (int d0 = 0; d0 < 4; ++d0) Ow[(long)orow * LDO + d0 * 32 + r32] = (unsigned short)(cvtpk(o[d0][r] * rli[r], 0.f) & 0xffffu); }
  __syncthreads();
#undef SLOAD
#undef BLD
#undef SWRITE
#undef SWAIT
#undef RESC
}
#undef KSWZ
#undef RSWZ
#undef SBAR
}

#define HD __device__ __forceinline__
#if defined(__HIPCC__)
typedef float cplx __attribute__((ext_vector_type(2)));
HD cplx mkc(float a, float b) { cplx r; r.x = a; r.y = b; return r; }
#endif
constexpr int FFT_M = 8192;
constexpr int FFT_BUF = 8704;
HD int fpad(int i) { return i + 2 * (i >> 5); }
HD int rev13(unsigned k) {
#if defined(__HIP_DEVICE_COMPILE__)
    return (int)(__brev(k) >> 19);
#else
    unsigned r = 0; for (int b = 0; b < 13; ++b) r |= ((k >> b) & 1u) << (12 - b); return (int)r;
#endif
}
HD void cs_rev(float rev, float& c, float& s) {
#if defined(__HIP_DEVICE_COMPILE__)
    c = __builtin_amdgcn_cosf(rev); s = __builtin_amdgcn_sinf(rev);
#else
    c = (float)cos(6.283185307179586 * (double)rev); s = (float)sin(6.283185307179586 * (double)rev);
#endif
}
HD cplx cmulf(cplx a, cplx b) { return mkc(a.x * b.x - a.y * b.y, a.x * b.y + a.y * b.x); }
HD cplx cmulcj(cplx a, cplx b) { return mkc(a.x * b.x + a.y * b.y, a.y * b.x - a.x * b.y); }
HD cplx cadd(cplx a, cplx b) { return mkc(a.x + b.x, a.y + b.y); }
HD cplx csub(cplx a, cplx b) { return mkc(a.x - b.x, a.y - b.y); }
HD cplx c16(int k) {
    const float C1 = 0.92387953251128674f, S1 = 0.38268343236508977f, R2 = 0.70710678118654752f;
    switch (k) { case 0: return mkc(1.f, 0.f); case 1: return mkc(C1, -S1); case 2: return mkc(R2, -R2); case 3: return mkc(S1, -C1);
                 case 4: return mkc(0.f, -1.f); case 5: return mkc(-S1, -C1); case 6: return mkc(-R2, -R2); default: return mkc(-C1, -S1); }
}
template <int SHIFT, int S0, bool INV, typename BufT>
HD void fft_pass16(int tid, BufT buf) {
#if defined(__HIP_DEVICE_COMPILE__)
    asm volatile("" : "+v"(tid));
#endif
    const int lo = tid & ((1 << SHIFT) - 1);
    const int base = ((tid >> SHIFT) << (SHIFT + 4)) | lo;
    cplx r[16];
#pragma unroll
    for (int j = 0; j < 16; ++j) r[j] = buf[fpad(base + (j << SHIFT))];
    cplx b[4];
    { float c, s; cs_rev((float)(lo << S0) * (1.0f / FFT_M), c, s); b[0] = mkc(c, -s); }
#pragma unroll
    for (int ss = 1; ss < 4; ++ss) b[ss] = cmulf(b[ss - 1], b[ss - 1]);
    if (!INV) {
#pragma unroll
        for (int ss = 0; ss < 4; ++ss) {
            const int hj = 8 >> ss;
#pragma unroll
            for (int j = 0; j < 16; ++j) {
                if (j & hj) continue;
                const int k16 = (j & (hj - 1)) << ss;
                const cplx w = k16 == 0 ? b[ss] : cmulf(b[ss], c16(k16));
                const cplx a = r[j], bb = r[j + hj];
                r[j] = cadd(a, bb);
                r[j + hj] = cmulf(csub(a, bb), w);
            }
        }
    } else {
#pragma unroll
        for (int ss = 3; ss >= 0; --ss) {
            const int hj = 8 >> ss;
#pragma unroll
            for (int j = 0; j < 16; ++j) {
                if (j & hj) continue;
                const int k16 = (j & (hj - 1)) << ss;
                const cplx w = k16 == 0 ? b[ss] : cmulf(b[ss], c16(k16));
                const cplx t = cmulcj(r[j + hj], w);
                const cplx a = r[j];
                r[j] = cadd(a, t);
                r[j + hj] = csub(a, t);
            }
        }
    }
#pragma unroll
    for (int j = 0; j < 16; ++j) buf[fpad(base + (j << SHIFT))] = r[j];
}
HD void combine_pair(cplx za, cplx zb, cplx ha, cplx hb, float c, float s, cplx& ok, cplx& omk) {
    const cplx w = mkc(c, -s);
    const cplx Ex = mkc(0.5f * (za.x + zb.x), 0.5f * (za.y - zb.y));
    const cplx Dx = mkc(za.x - zb.x, za.y + zb.y);
    const cplx Ox = mkc(0.5f * Dx.y, -0.5f * Dx.x);
    const cplx Eh = mkc(0.5f * (ha.x + hb.x), 0.5f * (ha.y - hb.y));
    const cplx Dh = mkc(ha.x - hb.x, ha.y + hb.y);
    const cplx Oh = mkc(0.5f * Dh.y, -0.5f * Dh.x);
    const cplx wOx = cmulf(w, Ox), wOh = cmulf(w, Oh);
    const cplx X1 = cadd(Ex, wOx), X2 = csub(Ex, wOx), H1 = cadd(Eh, wOh), H2 = csub(Eh, wOh);
    const cplx Y1 = cmulf(X1, H1), Y2 = cmulf(X2, H2);
    const cplx Ey = mkc(0.5f * (Y1.x + Y2.x), 0.5f * (Y1.y + Y2.y));
    const cplx Dy = mkc(0.5f * (Y1.x - Y2.x), 0.5f * (Y1.y - Y2.y));
    const cplx Oy = cmulf(Dy, mkc(c, s));
    ok = mkc(Ey.x - Oy.y, Ey.y + Oy.x);
    omk = mkc(Ey.x + Oy.y, -Ey.y + Oy.x);
}
template <typename BufT>
HD void fft_mid(int tid, BufT A, BufT B) {
#if defined(__HIP_DEVICE_COMPILE__)
    asm volatile("" : "+v"(tid));
#endif
#pragma unroll 1
    for (int q = 0; q < 5; ++q) {
        const int k = tid + 512 * q;
        if (k > 2048) break;
        const bool self = (k == 0) || (k == 2048);
        const int p1 = fpad(rev13((unsigned)k)), p2 = fpad(rev13((unsigned)(4096 - k) & 8191u));
        const cplx a0 = A[p1], a1 = A[p1 + 1], g0 = B[p1], g1 = B[p1 + 1];
        const cplx za_k = cadd(a0, a1), za_k4 = csub(a0, a1), zb_k = cadd(g0, g1), zb_k4 = csub(g0, g1);
        float c, s; cs_rev((float)k * (1.0f / (2 * FFT_M)), c, s);
        cplx o_k, o_k4, o_m, o_m4;
        if (self) {
            if (k == 0) { cplx d; combine_pair(za_k, za_k, zb_k, zb_k, c, s, o_k, d); combine_pair(za_k4, za_k4, zb_k4, zb_k4, -s, c, o_k4, d); }
            else { combine_pair(za_k, za_k4, zb_k, zb_k4, c, s, o_k, o_k4); }
            A[p1] = cadd(o_k, o_k4); A[p1 + 1] = csub(o_k, o_k4);
        } else {
            const cplx c0 = A[p2], c1 = A[p2 + 1], e0 = B[p2], e1 = B[p2 + 1];
            const cplx za_m = cadd(c0, c1), za_m4 = csub(c0, c1), zb_m = cadd(e0, e1), zb_m4 = csub(e0, e1);
            combine_pair(za_k, za_m4, zb_k, zb_m4, c, s, o_k, o_m4);
            combine_pair(za_k4, za_m, zb_k4, zb_m, -s, c, o_k4, o_m);
            A[p1] = cadd(o_k, o_k4); A[p1 + 1] = csub(o_k, o_k4);
            A[p2] = cadd(o_m, o_m4); A[p2 + 1] = csub(o_m, o_m4);
        }
    }
}
template <typename BufT>
HD void fft_put16(int tid, BufT buf, const float* x16) {
#pragma unroll
    for (int q = 0; q < 8; ++q) {
        buf[fpad(8 * tid + q)] = mkc(x16[2 * q], x16[2 * q + 1]);
        buf[fpad(4096 + 8 * tid + q)] = mkc(0.f, 0.f);
    }
}
template <typename BufT>
HD void fft_get16_mid(int tid, BufT buf, float* y16) {
#pragma unroll
    for (int q = 0; q < 8; ++q) { const cplx f = buf[fpad(2048 + 8 * tid + q)]; y16[2 * q] = f.x; y16[2 * q + 1] = f.y; }
}

typedef LAS cplx* lbuf_t;
__device__ __forceinline__ void fft_conv(int tid, lbuf_t A, lbuf_t B) {
    __syncthreads();
    fft_pass16<9, 0, false>(tid, A); fft_pass16<9, 0, false>(tid, B); __syncthreads();
    fft_pass16<5, 4, false>(tid, A); fft_pass16<5, 4, false>(tid, B); __syncthreads();
    fft_pass16<1, 8, false>(tid, A); fft_pass16<1, 8, false>(tid, B); __syncthreads();
    fft_mid(tid, A, B); __syncthreads();
    fft_pass16<1, 8, true>(tid, A); __syncthreads();
    fft_pass16<5, 4, true>(tid, A); __syncthreads();
    fft_pass16<9, 0, true>(tid, A); __syncthreads();
}
__device__ __forceinline__ void shortconv16(const bf16* hyT, int ch, int tid, const float* conv_w, const float* conv_b, float* out) {
    const bf16* p = hyT + (size_t)ch * 8192 + 16 * tid;
    const v4u a = *(const v4u*)p, b = *(const v4u*)(p + 8);
    float u[18];
    u[0] = tid > 0 ? bf2f(p[-1]) : 0.f; u[17] = tid < 511 ? bf2f(p[16]) : 0.f;
    const unsigned w[8] = {a.x, a.y, a.z, a.w, b.x, b.y, b.z, b.w};
#pragma unroll
    for (int i = 0; i < 8; ++i) { u[1 + 2 * i] = __builtin_bit_cast(float, w[i] << 16); u[2 + 2 * i] = __builtin_bit_cast(float, w[i] & 0xffff0000u); }
    const float w0 = conv_w[ch], w1 = conv_w[3072 + ch], w2 = conv_w[6144 + ch], bb = conv_b[ch];
#pragma unroll
    for (int i = 0; i < 16; ++i) out[i] = w0 * u[i] + w1 * u[i + 1] + w2 * u[i + 2] + bb;
}
__device__ __forceinline__ float block_sum512(float v, LAS float* red, int tid) {
    v = wave_sum(v);
    if ((tid & 63) == 0) red[tid >> 6] = v;
    __syncthreads();
    float s = 0.f;
#pragma unroll
    for (int i = 0; i < 8; ++i) s += red[i];
    __syncthreads();
    return s;
}
struct Raw16 { v4u a, b; unsigned short l, r; };
__device__ __forceinline__ Raw16 load_raw16(const bf16* hyT, int ch, int tid) {
    const bf16* p = hyT + (size_t)ch * 8192 + 16 * tid; Raw16 x;
    x.a = *(const v4u*)p; x.b = *(const v4u*)(p + 8); x.l = tid > 0 ? p[-1] : (unsigned short)0; x.r = tid < 511 ? p[16] : (unsigned short)0; return x;
}
__device__ __forceinline__ void shortconv_raw(const Raw16& x, float w0, float w1, float w2, float bb, float* out) {
    float u[18]; u[0] = bf2f(x.l); u[17] = bf2f(x.r);
    const unsigned w[8] = {x.a.x, x.a.y, x.a.z, x.a.w, x.b.x, x.b.y, x.b.z, x.b.w};
#pragma unroll
    for (int i = 0; i < 8; ++i) { u[1 + 2 * i] = __builtin_bit_cast(float, w[i] << 16); u[2 + 2 * i] = __builtin_bit_cast(float, w[i] & 0xffff0000u); }
#pragma unroll
    for (int i = 0; i < 16; ++i) out[i] = w0 * u[i] + w1 * u[i + 1] + w2 * u[i + 2] + bb;
}
__device__ __forceinline__ void hyena_unit(int c, const bf16* hyT, const float* conv_w, const float* conv_b, const float* hfilt, const float* skip, bf16* hyo, LAS unsigned char* lds, const int tid) {
    lbuf_t A = (lbuf_t)lds, B = (lbuf_t)(lds + FFT_BUF * 8);
    LAS float* red = (LAS float*)(lds + 2 * FFT_BUF * 8);
    const float* hp0 = hfilt + (size_t)c * 8192 + 16 * tid; const float* hp1 = hfilt + (size_t)(1024 + c) * 8192 + 16 * tid;
    v4f f0[4], f1[4];
#pragma unroll
    for (int i = 0; i < 4; ++i) f0[i] = *(const v4f*)(hp0 + 4 * i);
    const Raw16 rv = load_raw16(hyT, c, tid);
#pragma unroll
    for (int i = 0; i < 4; ++i) f1[i] = *(const v4f*)(hp1 + 4 * i);
    const Raw16 rx1 = load_raw16(hyT, 1024 + c, tid), rx2 = load_raw16(hyT, 2048 + c, tid);
    const float sk0 = skip[c], sk1 = skip[1024 + c];
    float cw[3][3], cb[3];
#pragma unroll
    for (int q = 0; q < 3; ++q) { const int ch = q * 1024 + c; cw[q][0] = conv_w[ch]; cw[q][1] = conv_w[3072 + ch]; cw[q][2] = conv_w[6144 + ch]; cb[q] = conv_b[ch]; }
    float v[16], y[16], g[16];
    float ss = 0.f;
#pragma unroll
    for (int i = 0; i < 4; ++i) { g[4 * i] = f0[i][0]; g[4 * i + 1] = f0[i][1]; g[4 * i + 2] = f0[i][2]; g[4 * i + 3] = f0[i][3]; }
#pragma unroll
    for (int i = 0; i < 16; ++i) ss += g[i] * g[i];
    fft_put16(tid, B, g);
    shortconv_raw(rv, cw[0][0], cw[0][1], cw[0][2], cb[0], v);
    fft_put16(tid, A, v);
    const float rn0 = (1.0f / sqrtf(block_sum512(ss, red, tid) + 1e-6f)) * (1.0f / FFT_M);
    fft_conv(tid, A, B);
    fft_get16_mid(tid, A, y);
    shortconv_raw(rx1, cw[1][0], cw[1][1], cw[1][2], cb[1], g);
#pragma unroll
    for (int i = 0; i < 16; ++i) v[i] = g[i] * (y[i] * rn0 + sk0 * v[i]);
    __syncthreads();
    ss = 0.f;
#pragma unroll
    for (int i = 0; i < 4; ++i) { g[4 * i] = f1[i][0]; g[4 * i + 1] = f1[i][1]; g[4 * i + 2] = f1[i][2]; g[4 * i + 3] = f1[i][3]; }
#pragma unroll
    for (int i = 0; i < 16; ++i) ss += g[i] * g[i];
    fft_put16(tid, B, g);
    fft_put16(tid, A, v);
    const float rn1 = (1.0f / sqrtf(block_sum512(ss, red, tid) + 1e-6f)) * (1.0f / FFT_M);
    fft_conv(tid, A, B);
    fft_get16_mid(tid, A, y);
    shortconv_raw(rx2, cw[2][0], cw[2][1], cw[2][2], cb[2], g);
    v4u o0, o1;
    float r[16];
#pragma unroll
    for (int i = 0; i < 16; ++i) r[i] = g[i] * (y[i] * rn1 + sk1 * v[i]);
    o0.x = pk2(r[0], r[1]); o0.y = pk2(r[2], r[3]); o0.z = pk2(r[4], r[5]); o0.w = pk2(r[6], r[7]);
    o1.x = pk2(r[8], r[9]); o1.y = pk2(r[10], r[11]); o1.z = pk2(r[12], r[13]); o1.w = pk2(r[14], r[15]);
    bf16* op = hyo + (size_t)c * 8192 + 16 * tid;
    *(v4u*)op = o0; *(v4u*)(op + 8) = o1;
    __syncthreads();
}

template <class ColFn>
__device__ __forceinline__ void cvt_item(const float* W, int K, int N, bf16* WT, int nblk, ColFn col, const float* kscale, LAS float* scr, int item, int lane) {
    const int kb = item / nblk, nb = item % nblk, k0 = 64 * kb, n0 = 64 * nb;
    const int nl = 4 * (lane & 15), kq = lane >> 4;
    const int s0 = col(n0 + nl), s1 = col(n0 + nl + 1), s2 = col(n0 + nl + 2), s3 = col(n0 + nl + 3);
    const bool vec = s0 >= 0 && (s0 & 3) == 0 && s1 == s0 + 1 && s2 == s0 + 2 && s3 == s0 + 3;
    v4f val[16];
    if (__all(vec)) {
#pragma unroll
        for (int i = 0; i < 16; ++i) val[i] = *(const v4f*)(W + (size_t)(k0 + 4 * i + kq) * N + s0);
    } else {
#pragma unroll
        for (int i = 0; i < 16; ++i) { const float* r = W + (size_t)(k0 + 4 * i + kq) * N;
            val[i][0] = s0 >= 0 ? r[s0] : 0.f; val[i][1] = s1 >= 0 ? r[s1] : 0.f; val[i][2] = s2 >= 0 ? r[s2] : 0.f; val[i][3] = s3 >= 0 ? r[s3] : 0.f; }
    }
#pragma unroll
    for (int i = 0; i < 16; ++i) { const int kk = 4 * i + kq; v4f x = val[i]; if (kscale) x = x * kscale[k0 + kk];
        LAS float* p = scr + kk * 65 + nl; p[0] = x[0]; p[1] = x[1]; p[2] = x[2]; p[3] = x[3]; }
    LDS_WAIT(); asm volatile("" ::: "memory");
    const int c = lane & 7;
#pragma unroll
    for (int j = 0; j < 8; ++j) { const int n = (lane >> 3) + 8 * j; const LAS float* s = scr + (8 * c) * 65 + n;
        v4u o; o.x = pk2(s[0 * 65], s[1 * 65]); o.y = pk2(s[2 * 65], s[3 * 65]); o.z = pk2(s[4 * 65], s[5 * 65]); o.w = pk2(s[6 * 65], s[7 * 65]);
        *(v4u*)(WT + (size_t)(n0 + n) * K + k0 + 8 * c) = o; }
    LDS_WAIT(); asm volatile("" ::: "memory");
}
struct ColId { __device__ __forceinline__ int operator()(int n) const { return n; } };
struct ColW13 { __device__ __forceinline__ int operator()(int n) const { return ((n & 255) >> 7) * 5632 + (n >> 8) * 128 + (n & 127); } };
__device__ __forceinline__ int rope_src(int j) { const int grp = j >> 5, jj = j & 31; return grp * 32 + (jj & 1) * 16 + (jj >> 1); }
struct ColWin { __device__ __forceinline__ int operator()(int n) const {
    if (n < 1024) return n; if (n < 4096) return 1088 + (n - 1024); if (n < 8192) return 4160 + (n - 4096); if (n < 8256) return 1024 + rope_src(n - 8192); return -1; } };
struct ColWuq { __device__ __forceinline__ int operator()(int n) const { const int h = n / 192, w = n - h * 192; return w < 128 ? n : h * 192 + 128 + rope_src(w - 128); } };

__device__ __forceinline__ void mod_unit(int unit, const float* w_mod, const float* b_mod, float* mods, const LAS float* sc  , LAS float* red  , int tid) {
    const int lane = tid & 63, wv = tid >> 6, col = unit * 64 + lane;
    float a0 = 0.f, a1 = 0.f;
    const float* wp = w_mod + (size_t)(wv * 256) * 18432 + col;
#pragma unroll 16
    for (int k = 0; k < 256; ++k) { const float w = wp[(size_t)k * 18432]; a0 += sc[wv * 256 + k] * w; a1 += sc[2048 + wv * 256 + k] * w; }
    red[(wv * 2 + 0) * 64 + lane] = a0; red[(wv * 2 + 1) * 64 + lane] = a1;
    __syncthreads();
    if (tid < 128) { const int v = tid >> 6; float s = b_mod[col];
#pragma unroll
        for (int w = 0; w < 8; ++w) s += red[(w * 2 + v) * 64 + lane];
        mods[v * 18432 + col] = s; }
    __syncthreads();
}
__device__ __forceinline__ void filter_unit(int unit, const float* w1, const float* b1, const float* w2, const float* b2, const float* w3, const float* freq, float* hfilt, LAS float* Z  , LAS float* H1  , LAS float* H2  , int tid) {
    const int t0 = (unit >> 2) * 64, oq = unit & 3, lane = tid & 63, wv = tid >> 6;
#pragma unroll 1
    for (int idx = tid; idx < 33 * 64; idx += 512) {
        const int i = idx >> 6, t = t0 + (idx & 63); float val;
        if (i == 0) val = (float)t / 8191.0f;
        else { const int b = (i - 1) & 15; const double band = 1e-4 + (double)b * ((15.0 - 1e-4) / 15.0); double rv = band * (double)t * (1.0 / 8192.0); rv -= floor(rv);
               const float ang = 6.283185307179586f * (float)rv; val = i <= 16 ? cosf(ang) : -sinf(ang); }
        Z[idx] = val;
    }
    __syncthreads();
    {   float acc[8];
#pragma unroll
        for (int q = 0; q < 8; ++q) acc[q] = b1[wv * 8 + q];
#pragma unroll 1
        for (int i = 0; i < 33; ++i) { const float zv = Z[i * 64 + lane];
#pragma unroll
            for (int q = 0; q < 8; ++q) acc[q] += zv * w1[i * 64 + wv * 8 + q]; }
#pragma unroll
        for (int q = 0; q < 8; ++q) H1[(wv * 8 + q) * 64 + lane] = sinf(freq[wv * 8 + q] * acc[q]);
    }
    __syncthreads();
    {   float acc[8];
#pragma unroll
        for (int q = 0; q < 8; ++q) acc[q] = b2[wv * 8 + q];
#pragma unroll 2
        for (int i = 0; i < 64; ++i) { const float hv = H1[i * 64 + lane];
#pragma unroll
            for (int q = 0; q < 8; ++q) acc[q] += hv * w2[i * 64 + wv * 8 + q]; }
#pragma unroll
        for (int q = 0; q < 8; ++q) H2[(wv * 8 + q) * 64 + lane] = sinf(freq[wv * 8 + q] * acc[q]);
    }
    __syncthreads();
    const int t = t0 + lane; const float dist = fabsf((float)t - 4096.0f) * (1.0f / 4096.0f);
#pragma unroll 1
    for (int it = 0; it < 8; ++it) {
        const int oc0 = oq * 512 + wv * 64 + it * 8; float acc[8];
#pragma unroll
        for (int q = 0; q < 8; ++q) acc[q] = 0.f;
#pragma unroll 2
        for (int j = 0; j < 64; ++j) { const float hv = H2[j * 64 + lane];
#pragma unroll
            for (int q = 0; q < 8; ++q) acc[q] += hv * w3[j * 2048 + oc0 + q]; }
#pragma unroll
        for (int q = 0; q < 8; ++q) { const int oc = oc0 + q, ch = oc & 1023;
            const float decay = fabsf(-3.0701134573253944f + (-15.350567286626973f + 3.0701134573253944f) * ((float)ch * (1.0f / 1023.0f)));
            hfilt[(size_t)oc * 8192 + t] = acc[q] * (__expf(-dist * decay) + 0.05f); }
    }
    __syncthreads();
}
__device__ __forceinline__ void norm_vals_bf16(const v4f (&v)[8], const float* g, const float* shift, const float* scale, bf16* orow, int lane) {
    float s = 0.f;
#pragma unroll
    for (int j = 0; j < 8; ++j) s += (v[j][0] * v[j][0] + v[j][1] * v[j][1]) + (v[j][2] * v[j][2] + v[j][3] * v[j][3]);
    const float rstd = 1.0f / sqrtf(wave_sum(s) * (1.0f / 2048.0f) + 1e-6f);
    v2u* o8 = (v2u*)orow + lane;
#pragma unroll
    for (int j = 0; j < 8; ++j) { const v4f gg = ((const v4f*)g)[lane + 64 * j], sh = ((const v4f*)shift)[lane + 64 * j], scl = ((const v4f*)scale)[lane + 64 * j];
        const v4f y = v[j] * rstd * gg * (scl + 1.0f) + sh; v2u w; w.x = pk2(y[0], y[1]); w.y = pk2(y[2], y[3]); o8[64 * j] = w; }
}
__device__ __forceinline__ void norm_row_bf16(const float* xrow, const float* g, const float* shift, const float* scale, bf16* orow, int lane) {
    const v4f* xr = (const v4f*)xrow + lane; v4f v[8];
#pragma unroll
    for (int j = 0; j < 8; ++j) v[j] = xr[64 * j];
    norm_vals_bf16(v, g, shift, scale, orow, lane);
}
__device__ __forceinline__ void final_norm_row(float* xrow, const float* g, int lane) {
    v4f* xr = (v4f*)xrow + lane; v4f v[8]; float s = 0.f;
#pragma unroll
    for (int j = 0; j < 8; ++j) { v[j] = xr[64 * j]; s += (v[j][0] * v[j][0] + v[j][1] * v[j][1]) + (v[j][2] * v[j][2] + v[j][3] * v[j][3]); }
    const float rstd = 1.0f / sqrtf(wave_sum(s) * (1.0f / 2048.0f) + 1e-6f);
#pragma unroll
    for (int j = 0; j < 8; ++j) xr[64 * j] = v[j] * rstd * ((const v4f*)g)[lane + 64 * j];
}
__device__ __forceinline__ void transpose_item(const bf16* hyo, bf16* hytok, int item, LAS unsigned short* scr  , int lane) {
    const int cb = item >> 7, tb = item & 127, c0 = cb * 64, t0 = tb * 64;
#pragma unroll 8
    for (int i = 0; i < 32; ++i) { const int ch = 2 * i + (lane >> 5); const unsigned val = *(const unsigned*)(hyo + (size_t)(c0 + ch) * 8192 + t0 + 2 * (lane & 31));
        *(LAS unsigned*)(scr + ch * 66 + 2 * (lane & 31)) = val; }
    LDS_WAIT(); asm volatile("" ::: "memory");
    const int q = lane & 7;
#pragma unroll
    for (int it = 0; it < 8; ++it) { const int t = 8 * it + (lane >> 3); const LAS unsigned short* s = scr + (8 * q) * 66 + t;
        v4u o; o.x = (unsigned)s[0] | ((unsigned)s[66] << 16); o.y = (unsigned)s[2 * 66] | ((unsigned)s[3 * 66] << 16); o.z = (unsigned)s[4 * 66] | ((unsigned)s[5 * 66] << 16); o.w = (unsigned)s[6 * 66] | ((unsigned)s[7 * 66] << 16);
        *(v4u*)(hytok + (size_t)(t0 + t) * 1024 + c0 + 8 * q) = o; }
    LDS_WAIT(); asm volatile("" ::: "memory");
}


typedef GAS unsigned gu32;
__device__ __forceinline__ unsigned long long rt() { return __builtin_amdgcn_s_memrealtime(); }
#define XB_TMO      128
#define XB_XCNT(j)  (256  + 64 * (j))
#define XB_XSUB(j)  (1280 + 64 * (j))
#define XB_XGEN(j)  (2304 + 64 * (j))
#define XB_TOP      3328
#define XB_TOPGEN   3392
#define XCD_BAR_WORDS 3456
#define XB_SPIN_CAP (1u << 18)

__device__ __forceinline__ unsigned xb_ld(unsigned* p)              { return __hip_atomic_load(p, __ATOMIC_RELAXED, __HIP_MEMORY_SCOPE_AGENT); }
__device__ __forceinline__ unsigned xb_add(unsigned* p, unsigned v) { return __hip_atomic_fetch_add(p, v, __ATOMIC_RELAXED, __HIP_MEMORY_SCOPE_AGENT); }
__device__ __forceinline__ unsigned xb_xcc_id() { return (unsigned)__builtin_amdgcn_s_getreg((3 << 11) | 20) & 0xFu; }
#define XB_SPIN(cond, bar) do { unsigned _sp = 0; while (cond) { __builtin_amdgcn_s_sleep(1); \
    if ((++_sp & 255u) == 0u) { if (xb_ld(&(bar)[XB_TMO])) break; if (_sp > XB_SPIN_CAP) { atomicAdd(&(bar)[XB_TMO], 1u); break; } } } } while (0)

struct XcdBarrier {
    unsigned* bar; unsigned x;
    volatile LAS unsigned* st;
};

__device__ __forceinline__ XcdBarrier xcd_barrier_post(unsigned* bar, volatile LAS unsigned* st, const bool t0) {
    XcdBarrier b; b.bar = bar; b.x = xb_xcc_id(); b.st = st;
    if (t0) (void)xb_add(&bar[XB_XCNT(b.x)], 1u);
    return b;
}
__device__ __forceinline__ void xcd_barrier_complete(unsigned* bar, unsigned x, unsigned& nloc, unsigned& nx) {
    const unsigned G = gridDim.x * gridDim.y * gridDim.z;
    unsigned sum, cnt, mine, sp = 0u;
    for (;;) {
        sum = 0u; cnt = 0u; mine = 0u;
#pragma unroll
        for (unsigned j = 0; j < 16; ++j) { const unsigned c = xb_ld(&bar[XB_XCNT(j)]); sum += c; cnt += (c > 0u) ? 1u : 0u; mine = (j == x) ? c : mine; }
        if (sum == G) break;
        __builtin_amdgcn_s_sleep(1);
        if ((++sp & 255u) == 0u) { if (xb_ld(&bar[XB_TMO])) break; if (sp > XB_SPIN_CAP) { atomicAdd(&bar[XB_TMO], 1u); break; } }
    }
    nloc = mine > 0u ? mine : 1u; nx = cnt > 0u ? cnt : 1u;
}

__device__ __forceinline__ void xcd_barrier(const XcdBarrier& b, const bool t0) {
    asm volatile("s_waitcnt vmcnt(0)" ::: "memory");
    __syncthreads();
    if (t0) {
        unsigned* bar = b.bar;
        __builtin_amdgcn_s_waitcnt(0);
        unsigned nloc = b.st[0], nx = b.st[1];
        if (nloc == 0u) { xcd_barrier_complete(bar, b.x, nloc, nx); b.st[0] = nloc; b.st[1] = nx; }
        const unsigned old = xb_add(&bar[XB_XSUB(b.x)], 1u);
        const unsigned gen = old / nloc;
        if (old + 1u == (gen + 1u) * nloc) {
            __builtin_amdgcn_fence(__ATOMIC_RELEASE, "agent");
            asm volatile("s_waitcnt vmcnt(0)" ::: "memory");
            const unsigned og = xb_add(&bar[XB_TOP], 1u);
            const unsigned tg = og / nx;
            if (og + 1u == (tg + 1u) * nx) xb_add(&bar[XB_TOPGEN], 1u);
            else XB_SPIN(xb_ld(&bar[XB_TOPGEN]) == tg, bar);
            __builtin_amdgcn_fence(__ATOMIC_ACQUIRE, "agent");
            xb_add(&bar[XB_XGEN(b.x)], 1u);
            asm volatile("s_waitcnt vmcnt(0)" ::: "memory");
        } else {
            XB_SPIN(xb_ld(&bar[XB_XGEN(b.x)]) == gen, bar);
            __builtin_amdgcn_fence(__ATOMIC_ACQUIRE, "agent");
            asm volatile("s_waitcnt vmcnt(0)" ::: "memory");
        }
    }
    __syncthreads();
}

namespace cg = cooperative_groups;
struct Args { const float* in[31]; float* dst; unsigned char* ws; };
enum { I_X = 0, I_C, I_CTX, I_CCTX, I_WMOD, I_BMOD, I_GFFN1, I_W13A, I_W2A, I_GMIX, I_WIN, I_GQ, I_WUQ, I_GKV, I_WUKV, I_WAO, I_HCW, I_HCB, I_HW1, I_HB1, I_HW2, I_HB2, I_HW3, I_HFREQ, I_HSKIP, I_WHO, I_WOUT, I_GFFN2, I_W13B, I_W2B, I_GFINAL };

template <int PH_LO, int PH_HI>
__global__ void __launch_bounds__(512, 2) mk_fwd(Args args) {
    extern __shared__ __attribute__((aligned(16))) unsigned char lds_raw[];
    LAS unsigned char* lds = (LAS unsigned char*)lds_raw;
    const int wave = __builtin_amdgcn_readfirstlane((int)threadIdx.x >> 6);
#define PHASE_TID() const int lane = lane_id_fresh(), tid = wave * 64 + lane; (void)tid; (void)lane
    const int G = gridDim.x, bx = blockIdx.x;
    const int vcu = (G % 8 == 0) ? (bx % 8) * (G / 8) + bx / 8 : bx;
    const int gw = vcu * 8 + wave, NGW = G * 8;
    typedef const __attribute__((address_space(4))) Args* kargp_t;
    const kargp_t kp0 = (kargp_t)__builtin_amdgcn_kernarg_segment_ptr();
#define KP() ({ kargp_t p_ = kp0; asm volatile("" : "+s"(p_)); p_; })
#define WSB(off) (KP()->ws + (off))
#define INP(i) (KP()->in[i])
#define mods ((float*)WSB(WS_MODS))
#define rope ((float*)WSB(WS_ROPE))
#define qss ((float*)WSB(WS_QSS))
#define kvss ((float*)WSB(WS_KVSS))
#define W13A ((bf16*)WSB(WS_W13A))
#define W2A ((bf16*)WSB(WS_W2A))
#define WIN ((bf16*)WSB(WS_WIN))
#define WUQ ((bf16*)WSB(WS_WUQ))
#define WUKV ((bf16*)WSB(WS_WUKV))
#define WAO ((bf16*)WSB(WS_WAO))
#define WHO ((bf16*)WSB(WS_WHO))
#define WOUT ((bf16*)WSB(WS_WOUT))
#define W13B ((bf16*)WSB(WS_W13B))
#define W2B ((bf16*)WSB(WS_W2B))
#define HN ((bf16*)WSB(WS_HN))
#define ACT ((bf16*)WSB(WS_ACT))
#define X1 ((float*)WSB(WS_X1))
#define HYT ((bf16*)WSB(WS_HYT))
#define KV ((bf16*)WSB(WS_KV))
#define Q ((bf16*)WSB(WS_Q))
#define T ((float*)WSB(WS_T))
#define HYO ((bf16*)WSB(WS_HYO))
#define AX ((bf16*)WSB(WS_AX))
#define GATES ((bf16*)WSB(WS_GATES))
#define PQ ((bf16*)WSB(WS_PQ))
#define PKV ((bf16*)WSB(WS_PKV))
#define KR ((bf16*)WSB(WS_KR))
#define HYTOK ((bf16*)WSB(WS_HYTOK))
#define Y ((bf16*)WSB(WS_Y))
#define out (KP()->dst)
#define hfilt (KP()->dst)
    {   const int t0_ = wave * 64 + lane_id_fresh();
        for (int u = t0_; u < 128; u += 512) ((LAS unsigned*)(lds + LDS_CTL_OFF))[u] = 0u;
        __syncthreads(); }
    XcdBarrier bar = xcd_barrier_post((unsigned*)(kp0->ws + WS_CTL) + 4096, (volatile LAS unsigned*)(lds + LDS_CTL_OFF) + 8, wave == 0 && lane_id_fresh() == 0);
    constexpr int lo = PH_LO, hi = PH_HI;
#ifndef PHASE_MASK
#define PHASE_MASK 0x3fff
#endif
#define IN(k) ((((PHASE_MASK) >> (k)) & 1) && lo <= (k) && (k) < hi)
#ifndef REPEAT_PHASE
#define REPEAT_PHASE -1
#endif
#define REP(k) for (int rep_ = 0; rep_ < ((k) == REPEAT_PHASE ? 2 : 1); ++rep_)
#define SEAM(k) do { if (IN(k) && IN((k) + 1)) { if ((k) == 0) cg::this_grid().sync(); else xcd_barrier(bar, wave == 0 && lane_id_fresh() == 0); } } while (0)

    if (IN(0)) REP(0) {
        PHASE_TID();
        LAS float* sc = (LAS float*)lds; LAS float* red = (LAS float*)(lds + 16384);
        for (int i = tid; i < 4096; i += 512) { const float v = i < 2048 ? INP(I_C)[i] : INP(I_CCTX)[i - 2048]; sc[i] = v * fast_sigmoid(v); }
        __syncthreads();
        for (int u = bx; u < 288; u += G) mod_unit(u, INP(I_WMOD), INP(I_BMOD), mods, sc, red, tid);
        __syncthreads();
        if (bx == 0) for (int idx = tid; idx < 2048; idx += 512) { const int pos = idx >> 4, p = idx & 15; const float inv = powf(10000.0f, -(float)p * (1.0f / 16.0f)); const float ang = (float)pos * inv;
            rope[2 * idx] = cosf(ang); rope[2 * idx + 1] = sinf(ang); }
        {   LAS float* scr = (LAS float*)(lds + wave * 16640);
            constexpr int I13 = 32 * 176, I2 = 88 * 32, IIN = 32 * 132, IUQ = 8 * 48, IUKV = 8 * 64, IAO = 32 * 32, IHO = 16 * 32, IOUT = 32 * 32;
            constexpr int NITEMS = 2 * I13 + 2 * I2 + IIN + IUQ + IUKV + IAO + IHO + IOUT;
            for (int it = gw; it < NITEMS; it += NGW) {
                int r = it;
                if (r < I13) { cvt_item(INP(I_W13A), 2048, 11264, W13A, 176, ColW13(), nullptr, scr, r, lane); continue; } r -= I13;
                if (r < I2) { cvt_item(INP(I_W2A), 5632, 2048, W2A, 32, ColId(), nullptr, scr, r, lane); continue; } r -= I2;
                if (r < IIN) { cvt_item(INP(I_WIN), 2048, 8256, WIN, 132, ColWin(), nullptr, scr, r, lane); continue; } r -= IIN;
                if (r < IUQ) { cvt_item(INP(I_WUQ), 512, 3072, WUQ, 48, ColWuq(), INP(I_GQ), scr, r, lane); continue; } r -= IUQ;
                if (r < IUKV) { cvt_item(INP(I_WUKV), 512, 4096, WUKV, 64, ColId(), INP(I_GKV), scr, r, lane); continue; } r -= IUKV;
                if (r < IAO) { cvt_item(INP(I_WAO), 2048, 2048, WAO, 32, ColId(), nullptr, scr, r, lane); continue; } r -= IAO;
                if (r < IHO) { cvt_item(INP(I_WHO), 1024, 2048, WHO, 32, ColId(), nullptr, scr, r, lane); continue; } r -= IHO;
                if (r < IOUT) { cvt_item(INP(I_WOUT), 2048, 2048, WOUT, 32, ColId(), nullptr, scr, r, lane); continue; } r -= IOUT;
                if (r < I13) { cvt_item(INP(I_W13B), 2048, 11264, W13B, 176, ColW13(), nullptr, scr, r, lane); continue; } r -= I13;
                cvt_item(INP(I_W2B), 5632, 2048, W2B, 32, ColId(), nullptr, scr, r, lane);
            }
        }
        __syncthreads();
        for (int u = bx; u < 512; u += G)
            filter_unit(u, INP(I_HW1), INP(I_HB1), INP(I_HW2), INP(I_HB2), INP(I_HW3), INP(I_HFREQ), hfilt, (LAS float*)lds, (LAS float*)(lds + 16384), (LAS float*)(lds + 32768), tid);
    }
    SEAM(0);
    if (IN(1)) REP(1) {
        PHASE_TID();
        for (int row = gw; row < MTOT; row += NGW) {
            const bool isc = row >= SEQ; const float* src = isc ? INP(I_CTX) + (size_t)(row - SEQ) * DM : INP(I_X) + (size_t)row * DM; const float* mv = mods + (isc ? 18432 : 0);
            norm_row_bf16(src, INP(I_GFFN1), mv + 0 * DM, mv + 1 * DM, HN + (size_t)row * DM, lane);
        }
    }
    SEAM(1);
    if (IN(2)) REP(2) {
        PHASE_TID();
        pg8::Gemm g{HN, W13A, MTOT, 11264, 2048}; pg8::StaticOrder S; S.init(MTOT, 11264, G, bx);
        pg8::EpiSwiGLU E{ACT, DFF};
        pg8::gemm_phase<pg8::EpiSwiGLU, pg8::StaticOrder, true, true>(lds, g, S, E, tid);
    }
    SEAM(2);
    if (IN(3)) REP(3) {
        PHASE_TID();
        {   pg8::Gemm g{ACT, W2A, SEQ, 2048, DFF}; pg8::StaticOrder S; S.init(SEQ, 2048, G, bx);
            pg8::EpiResid E{INP(I_X), INP(I_CTX), mods + 2 * DM, mods + 18432 + 2 * DM, X1, 0.5f};
            pg8::gemm_phase<pg8::EpiResid, pg8::StaticOrder, true, true>(lds, g, S, E, tid); }
        {
            pg8::Gemm g{ACT + (size_t)SEQ * DFF, W2A, 256, 2048, 512, DFF, 512 * 2}; pg8::SplitKOrder S; S.init(11, 8, G, G - 1 - bx);
            pg8::EpiSlab E{(float*)WSB(WS_KV)};
            pg8::gemm_phase<pg8::EpiSlab, pg8::SplitKOrder, true, true>(lds, g, S, E, tid); }
    }
    SEAM(3);
    if (IN(4)) REP(4) {
        PHASE_TID();
        for (int row = gw; row < MTOT; row += NGW) {
            if (row < SEQ) { norm_row_bf16(X1 + (size_t)row * DM, INP(I_GMIX), mods + 3 * DM, mods + 4 * DM, HN + (size_t)row * DM, lane); }
            else {
                const float* mv = mods + 18432; const v4f* cr = (const v4f*)(INP(I_CTX) + (size_t)(row - SEQ) * DM) + lane; const v4f* sl = (const v4f*)((const float*)WSB(WS_KV) + (size_t)(row - SEQ) * DM) + lane;
                v4f v[8];
#pragma unroll
                for (int j = 0; j < 8; ++j) { v4f a = sl[64 * j];
#pragma unroll
                    for (int s = 1; s < 11; ++s) a += sl[(size_t)s * (256 * 2048 / 4) + 64 * j];
                    v[j] = cr[64 * j] + a * (((const v4f*)(mv + 2 * DM))[lane + 64 * j] * 0.5f); }
                norm_vals_bf16(v, INP(I_GMIX), mv + 3 * DM, mv + 4 * DM, HN + (size_t)row * DM, lane);
            }
        }
    }
    SEAM(4);
    if (IN(5)) REP(5) {
        PHASE_TID();
        pg8::Gemm g{HN, WIN, MTOT, NINP, 2048}; pg8::InProjOrder S; S.init(G, bx);
        pg8::EpiInProj E{PQ, PKV, KR, HYT, GATES, qss, kvss, rope};
        pg8::gemm_phase<pg8::EpiInProj, pg8::InProjOrder, true, true>(lds, g, S, E, tid);
    }
    SEAM(5);
    if (IN(6)) REP(6) {
        PHASE_TID();
        {   pg8::Gemm g{PQ, WUQ, SEQ, 3072, 512}; pg8::StaticOrder S; S.init(SEQ, 3072, G, bx);
            pg8::EpiQUp E{Q, qss, rope};
            pg8::gemm_phase<pg8::EpiQUp, pg8::StaticOrder, true, true>(lds, g, S, E, tid); }
        {   pg8::Gemm g{PKV, WUKV, MTOT, 4096, 512}; pg8::StaticOrder S; S.init(MTOT, 4096, G, bx);
            pg8::EpiKVUp E{KV, kvss};
            pg8::gemm_phase<pg8::EpiKVUp, pg8::StaticOrder, true, true>(lds, g, S, E, tid); }
        __syncthreads();
        for (int c = bx; c < HYW; c += G) hyena_unit(c, HYT, INP(I_HCW), INP(I_HCB), hfilt, INP(I_HSKIP), HYO, lds, tid);
    }
    SEAM(6);
    if (IN(7)) REP(7) {
        PHASE_TID();
        for (int i = 0; ; ++i) {
            const int u = i * G + vcu; if (u >= HEADS * (SEQ / 256)) break;
            const int head = u >> 5, qb = u & 31;
            { const bf16* kvb = KV; att::attn_unit(Q + (size_t)(qb * 256) * 3072 + head * DQH, kvb, kvb + head * 256, KR, AX + (size_t)(qb * 256) * DM + head * DVH, MTOT, (LAS char*)lds, tid); }
        }
        __syncthreads();
        LAS unsigned short* scr = (LAS unsigned short*)(lds + wave * 16384);
        for (int it = gw; it < 2048; it += NGW) transpose_item(HYO, HYTOK, it, scr, lane);
    }
    SEAM(7);
    if (IN(8)) REP(8) {
        PHASE_TID();
        pg8::StaticOrder S; S.init(SEQ, 2048, G, bx);
        {   pg8::Gemm g{AX, WAO, SEQ, 2048, 2048}; pg8::EpiMerge<0> E{GATES, T, Y};
            pg8::gemm_phase<pg8::EpiMerge<0>, pg8::StaticOrder, true, true>(lds, g, S, E, tid); }
        {   pg8::Gemm g{HYTOK, WHO, SEQ, 2048, 1024}; pg8::EpiMerge<1> E{GATES, T, Y};
            pg8::gemm_phase<pg8::EpiMerge<1>, pg8::StaticOrder, true, true>(lds, g, S, E, tid); }
    }
    SEAM(8);
    if (IN(9)) REP(9) {
        PHASE_TID();
        pg8::Gemm g{Y, WOUT, SEQ, 2048, 2048}; pg8::StaticOrder S; S.init(SEQ, 2048, G, bx);
        pg8::EpiResid E{X1, X1, mods + 5 * DM, mods + 5 * DM, out, 1.0f};
        pg8::gemm_phase<pg8::EpiResid, pg8::StaticOrder, true, true>(lds, g, S, E, tid);
    }
    SEAM(9);
    if (IN(10)) REP(10) {
        PHASE_TID();
        for (int row = gw; row < SEQ; row += NGW) norm_row_bf16(out + (size_t)row * DM, INP(I_GFFN2), mods + 6 * DM, mods + 7 * DM, HN + (size_t)row * DM, lane);
    }
    SEAM(10);
    if (IN(11)) REP(11) {
        PHASE_TID();
        pg8::Gemm g{HN, W13B, SEQ, 11264, 2048}; pg8::StaticOrder S; S.init(SEQ, 11264, G, bx);
        pg8::EpiSwiGLU E{ACT, DFF};
        pg8::gemm_phase<pg8::EpiSwiGLU, pg8::StaticOrder, true, true>(lds, g, S, E, tid);
    }
    SEAM(11);
    if (IN(12)) REP(12) {
        PHASE_TID();
        pg8::Gemm g{ACT, W2B, SEQ, 2048, DFF}; pg8::StaticOrder S; S.init(SEQ, 2048, G, bx);
        pg8::EpiResid E{out, out, mods + 8 * DM, mods + 8 * DM, out, 0.5f};
        pg8::gemm_phase<pg8::EpiResid, pg8::StaticOrder, true, true>(lds, g, S, E, tid);
    }
    SEAM(12);
    if (IN(13)) REP(13) {
        PHASE_TID();
        for (int row = gw; row < SEQ; row += NGW) final_norm_row(out + (size_t)row * DM, INP(I_GFINAL), lane);
    }
#undef IN
#undef SEAM
#undef PHASE_TID
#undef KP
#undef WSB
#undef INP
#undef mods
#undef rope
#undef qss
#undef kvss
#undef W13A
#undef W2A
#undef WIN
#undef WUQ
#undef WUKV
#undef WAO
#undef WHO
#undef WOUT
#undef W13B
#undef W2B
#undef HN
#undef ACT
#undef X1
#undef HYT
#undef KV
#undef Q
#undef T
#undef HYO
#undef AX
#undef GATES
#undef PQ
#undef PKV
#undef KR
#undef HYTOK
#undef Y
#undef out
#undef hfilt
}


#ifdef DBG_STOP
struct DumpArgs { const void* p[4]; size_t n[4]; int isbf[4]; float* out; size_t nout; };
__global__ void __launch_bounds__(256) dbg_dump(DumpArgs d) {
    for (size_t i = blockIdx.x * 256ull + threadIdx.x; i < d.nout; i += (size_t)gridDim.x * 256ull) {
        float s = 0.f;
        for (int b = 0; b < 4; ++b) { if (!d.p[b]) continue;
            for (size_t j = i; j < d.n[b]; j += d.nout) s += d.isbf[b] ? bf2f(((const unsigned short*)d.p[b])[j]) : ((const float*)d.p[b])[j]; }
        d.out[i] = s;
    }
}
#endif
typedef void (*kern_t)(Args);
template <int K> struct PhaseTab { static void fill(kern_t* t) { t[K] = mk_fwd<K, K + 1>; PhaseTab<K - 1>::fill(t); } };
template <> struct PhaseTab<-1> { static void fill(kern_t*) {} };
extern "C" void kernel_launch(void* const* d_in, const int* in_sizes, int n_in, void* d_out, int out_size, void* d_ws, size_t ws_size, hipStream_t stream) {
    static int grid = 0;
    static kern_t tab[N_PHASES];
    if (grid == 0) {
        if (n_in != 31 || in_sizes[0] != SEQ * DM || out_size != SEQ * DM || ws_size < WS_END) {
            fprintf(stderr, "kernel_launch: unexpected problem: n_in %d in0 %d out %d ws %zu (need %zu); nothing launched\n", n_in, n_in > 0 ? in_sizes[0] : -1, out_size, ws_size, (size_t)WS_END); grid = -1; return; }
        int dev = 0, cus = 0;
        if (hipGetDevice(&dev) != hipSuccess || hipDeviceGetAttribute(&cus, hipDeviceAttributeMultiprocessorCount, dev) != hipSuccess) { grid = -1; return; }
#if MK_N_LAUNCHES == 1
        if (hipFuncSetAttribute((const void*)mk_fwd<0, N_PHASES>, hipFuncAttributeMaxDynamicSharedMemorySize, LDS_BYTES) != hipSuccess) { fprintf(stderr, "kernel_launch: hipFuncSetAttribute failed\n"); grid = -1; return; }
        int per_cu = 0;
        if (hipOccupancyMaxActiveBlocksPerMultiprocessor(&per_cu, (const void*)mk_fwd<0, N_PHASES>, 512, LDS_BYTES) != hipSuccess || per_cu < 1) { fprintf(stderr, "kernel_launch: occupancy query says %d blocks per CU\n", per_cu); }
#else
        PhaseTab<N_PHASES - 1>::fill(tab);
        for (int i = 0; i < N_PHASES; ++i)
            if (hipFuncSetAttribute((const void*)tab[i], hipFuncAttributeMaxDynamicSharedMemorySize, LDS_BYTES) != hipSuccess) { fprintf(stderr, "kernel_launch: hipFuncSetAttribute failed (phase %d)\n", i); grid = -1; return; }
#endif
        (void)hipGetLastError();
        grid = cus;
    }
    if (grid < 0) return;
    (void)hipMemsetAsync((char*)d_ws + WS_CTL, 0, 65536, stream);
    Args a{};
    for (int i = 0; i < 31; ++i) a.in[i] = (const float*)d_in[i];
    a.dst = (float*)d_out; a.ws = (unsigned char*)d_ws;
#if MK_N_LAUNCHES == 1
    void* kargs[] = {&a};
    hipError_t e = hipLaunchCooperativeKernel((const void*)mk_fwd<0, N_PHASES>, dim3(grid), dim3(512), kargs, LDS_BYTES, stream);
    if (e != hipSuccess) fprintf(stderr, "kernel_launch: cooperative launch failed: %s (grid %d)\n", hipGetErrorString(e), grid);
#else
#ifdef DBG_STOP
    for (int li = 0; li <= DBG_STOP; ++li) hipLaunchKernelGGL(tab[li], dim3(grid), dim3(512), LDS_BYTES, stream, a);
    {   DumpArgs d{}; unsigned char* w = (unsigned char*)d_ws; d.out = (float*)d_out; d.nout = (size_t)SEQ * DM;
#if DBG_STOP == 6
        d.p[0] = w + WS_Q; d.n[0] = (size_t)8192 * 3072; d.isbf[0] = 1; d.p[1] = w + WS_KV; d.n[1] = (size_t)MTOT * 4096; d.isbf[1] = 1; d.p[2] = w + WS_HYO; d.n[2] = (size_t)1024 * 8192; d.isbf[2] = 1;
#elif DBG_STOP == 5
        d.p[0] = w + WS_GATES; d.n[0] = (size_t)8192 * 4096; d.isbf[0] = 1; d.p[1] = w + WS_PQ; d.n[1] = (size_t)8192 * 512 + (size_t)MTOT * 512 + (size_t)MTOT * 64; d.isbf[1] = 1; d.p[2] = w + WS_HYT; d.n[2] = (size_t)3072 * 8192; d.isbf[2] = 1; d.p[3] = w + WS_QSS; d.n[3] = (size_t)MTOT * 8; d.isbf[3] = 0;
#elif DBG_STOP == 3
        d.p[0] = w + WS_X1; d.n[0] = (size_t)MTOT * 2048; d.isbf[0] = 0;
#elif DBG_STOP == 2
        d.p[0] = w + WS_ACT; d.n[0] = (size_t)MTOT * DFF; d.isbf[0] = 1;
#elif DBG_STOP == 1
        d.p[0] = w + WS_HN; d.n[0] = (size_t)MTOT * 2048; d.isbf[0] = 1;
#elif DBG_STOP == 0
        d.p[0] = w + WS_W13A; d.n[0] = (WS_HN - WS_W13A) / 2; d.isbf[0] = 1; d.p[1] = w + WS_MODS; d.n[1] = 2 * 18432; d.isbf[1] = 0; d.p[2] = w + WS_ROPE; d.n[2] = 4096; d.isbf[2] = 0;
#elif DBG_STOP == 7
        d.p[0] = w + WS_AX; d.n[0] = (size_t)8192 * 2048; d.isbf[0] = 1; d.p[1] = w + WS_HYTOK; d.n[1] = (size_t)8192 * 1024; d.isbf[1] = 1;
#elif DBG_STOP == 8
        d.p[0] = w + WS_Y; d.n[0] = (size_t)8192 * 2048; d.isbf[0] = 1;
#endif
        hipLaunchKernelGGL(dbg_dump, dim3(2048), dim3(256), 0, stream, d); }
#else
    for (int li = 0; li < N_PHASES; ++li) hipLaunchKernelGGL(tab[li], dim3(grid), dim3(512), LDS_BYTES, stream, a);
#endif
    const hipError_t le = hipPeekAtLastError();
    if (le != hipSuccess) fprintf(stderr, "kernel_launch: launch failed: %s\n", hipGetErrorName(le));
#endif
}
```
